# Optimizing an MI355X kernel written in HIP

```python
import math
import jax, jax.numpy as jnp
from jax import lax
import numpy as np

D_MODEL = 1024
BATCH = 16
SEQ = 2048
DEPTH = 4

CHUNK = 64
HEAD_DIM = 64
POOL_WINDOWS = (2, 4, 8, 16)
POOL_WIDTH = D_MODEL // 4
POOL_GROUP = POOL_WIDTH // len(POOL_WINDOWS)
DSA_WIDTH = 3 * D_MODEL // 8
DSA_HEADS = DSA_WIDTH // HEAD_DIM
FOX_WIDTH = 3 * D_MODEL // 8
FOX_HEADS = FOX_WIDTH // HEAD_DIM
MIX_WIDTH = POOL_WIDTH + DSA_WIDTH + FOX_WIDTH
IDX_HEADS = 8
IDX_DIM = 32
DSA_TOPK_MAX = 256
DSA_QBLOCK = 32
FOX_QBLOCK = 128
RMS_EPS = 1e-6
IN_SIZES = (
    POOL_WIDTH, POOL_WIDTH,
    DSA_WIDTH, DSA_WIDTH, DSA_WIDTH, DSA_WIDTH,
    IDX_HEADS * IDX_DIM, IDX_DIM, IDX_HEADS,
    FOX_WIDTH, FOX_WIDTH, FOX_WIDTH, FOX_WIDTH,
    FOX_HEADS,
)
IN_COLS = 2 * POOL_WIDTH + 4 * DSA_WIDTH + IDX_HEADS * IDX_DIM + IDX_DIM + IDX_HEADS + 4 * FOX_WIDTH + FOX_HEADS

kernel_name = 'hybrid_pool_dsa_fox_chunk_causal'


def rmsnorm(x, g):
    xf = x.astype(jnp.float32)
    y = xf * lax.rsqrt(jnp.mean(xf * xf, axis=-1, keepdims=True) + RMS_EPS)
    return (y * g.astype(jnp.float32)).astype(x.dtype)


def split_columns(z):
    parts = []
    off = 0
    for n in IN_SIZES:
        parts.append(z[..., off:off + n])
        off += n
    return parts


def pool_mixer(v, w_grp, scale):
    B, L, _ = v.shape
    vf = v.astype(jnp.float32)
    cs = jnp.pad(jnp.cumsum(vf, axis=1), ((0, 0), (1, 0), (0, 0)))
    t = jnp.arange(L)
    outs = []
    for gi, w in enumerate(POOL_WINDOWS):
        sl = slice(gi * POOL_GROUP, (gi + 1) * POOL_GROUP)
        c = cs[:, :, sl]
        lo = jnp.maximum(t + 1 - w, 0)
        win_sum = c[:, t + 1] - c[:, lo]
        cnt = (t + 1 - lo).astype(jnp.float32)[None, :, None]
        outs.append(win_sum / cnt - vf[:, :, sl])
    p = jnp.stack(outs, axis=2).astype(v.dtype)
    y = jnp.einsum('blgc,gcd->blgd', p, w_grp).reshape(B, L, POOL_WIDTH)
    return y * scale


def dsa_mixer(q, k, v, iq, ik, iw, topk):
    B, L, H, dh = q.shape
    n_blocks = L // DSA_QBLOCK
    key_pos = jnp.arange(L)
    sm_scale = 1.0 / math.sqrt(dh)
    gather = jax.vmap(lambda arr, idx: arr[idx])

    def block(bi):
        start = bi * DSA_QBLOCK
        qb = lax.dynamic_slice_in_dim(q, start, DSA_QBLOCK, axis=1)
        iqb = lax.dynamic_slice_in_dim(iq, start, DSA_QBLOCK, axis=1)
        iwb = lax.dynamic_slice_in_dim(iw, start, DSA_QBLOCK, axis=1)
        qpos = start + jnp.arange(DSA_QBLOCK)
        limit = (qpos // CHUNK + 1) * CHUNK
        dots = jnp.einsum('bqhd,bsd->bqhs', iqb, ik).astype(jnp.float32)
        score = jnp.einsum('bqh,bqhs->bqs', iwb.astype(jnp.float32), jax.nn.relu(dots))
        admissible = key_pos[None, None, :] < limit[None, :, None]
        score = jnp.where(admissible, score, -jnp.inf)
        _, sel = lax.top_k(score, topk)
        valid = sel < limit[None, :, None]
        kg = gather(k, sel)
        vg = gather(v, sel)
        s = jnp.einsum('bqhd,bqkhd->bqhk', qb, kg).astype(jnp.float32) * sm_scale
        s = jnp.where(valid[:, :, None, :], s, -jnp.inf)
        p = jax.nn.softmax(s, axis=-1).astype(v.dtype)
        return jnp.einsum('bqhk,bqkhd->bqhd', p, vg)

    o = lax.map(block, jnp.arange(n_blocks))
    return jnp.transpose(o, (1, 0, 2, 3, 4)).reshape(B, L, H, dh)


def fox_mixer(q, k, v, log_f):
    B, L, H, dh = q.shape
    sm_scale = 1.0 / math.sqrt(dh)
    F = jnp.transpose(jnp.cumsum(log_f, axis=1), (0, 2, 1))
    outs = []
    for bi in range(L // FOX_QBLOCK):
        s0 = bi * FOX_QBLOCK
        e = s0 + FOX_QBLOCK
        s = jnp.einsum('bqhd,bkhd->bhqk', q[:, s0:e], k[:, :e]).astype(jnp.float32) * sm_scale
        s = s + F[:, :, s0:e, None] - F[:, :, None, :e]
        mask = jnp.arange(s0, e)[:, None] >= jnp.arange(e)[None, :]
        s = jnp.where(mask[None, None], s, -jnp.inf)
        p = jax.nn.softmax(s, axis=-1).astype(v.dtype)
        outs.append(jnp.einsum('bhqk,bkhd->bqhd', p, v[:, :e]))
    return jnp.concatenate(outs, axis=1)


def setup_inputs(seed: int = 0) -> dict:
    key = jax.random.key(seed)
    ks = jax.random.split(key, 9)
    x = jax.random.normal(ks[0], (BATCH, SEQ, D_MODEL), jnp.float32)
    w_in = jax.random.normal(ks[1], (DEPTH, D_MODEL, IN_COLS), jnp.float32) * D_MODEL ** -0.5
    norm_g = 1.0 + 0.02 * jax.random.normal(ks[2], (DEPTH, D_MODEL), jnp.float32)
    pool_w = jax.random.normal(ks[3], (DEPTH, len(POOL_WINDOWS), POOL_GROUP, POOL_GROUP), jnp.float32) * POOL_GROUP ** -0.5
    pool_scale = 1.0 + 0.1 * jax.random.normal(ks[4], (DEPTH, POOL_WIDTH), jnp.float32)
    fox_bf = 3.0 + 0.5 * jax.random.normal(ks[5], (DEPTH, FOX_HEADS), jnp.float32)
    w_out = jax.random.normal(ks[6], (DEPTH, MIX_WIDTH, D_MODEL), jnp.float32) * MIX_WIDTH ** -0.5
    final_g = 1.0 + 0.02 * jax.random.normal(ks[7], (D_MODEL,), jnp.float32)
    return {'x': x, 'w_in': w_in, 'norm_g': norm_g, 'pool_w': pool_w, 'pool_scale': pool_scale,
            'fox_bf': fox_bf, 'w_out': w_out, 'final_g': final_g}


def reference(x, w_in, norm_g, pool_w, pool_scale, fox_bf, w_out, final_g):
    B, L, _ = x.shape
    topk = min(DSA_TOPK_MAX, L // 4)
    idx_w_scale = IDX_HEADS ** -0.5
    for layer in range(DEPTH):
        h = rmsnorm(x, norm_g[layer])
        z = jnp.einsum('bld,dc->blc', h, w_in[layer])
        (pv, pg, dq, dk, dv, dg, iq, ik, iw, fq, fk, fv, fg, ff) = split_columns(z)
        a_out = pool_mixer(pv, pool_w[layer], pool_scale[layer]) * jax.nn.silu(pg)
        b_o = dsa_mixer(dq.reshape(B, L, DSA_HEADS, HEAD_DIM), dk.reshape(B, L, DSA_HEADS, HEAD_DIM),
                        dv.reshape(B, L, DSA_HEADS, HEAD_DIM), iq.reshape(B, L, IDX_HEADS, IDX_DIM),
                        ik, iw * idx_w_scale, topk)
        b_out = b_o.reshape(B, L, DSA_WIDTH) * jax.nn.silu(dg)
        log_f = jax.nn.log_sigmoid(ff.astype(jnp.float32) + fox_bf[layer].astype(jnp.float32))
        c_o = fox_mixer(fq.reshape(B, L, FOX_HEADS, HEAD_DIM), fk.reshape(B, L, FOX_HEADS, HEAD_DIM),
                        fv.reshape(B, L, FOX_HEADS, HEAD_DIM), log_f)
        c_out = c_o.reshape(B, L, FOX_WIDTH) * jax.nn.silu(fg)
        mixed = jnp.concatenate([a_out, b_out, c_out], axis=-1)
        x = x + jnp.einsum('blc,cd->bld', mixed, w_out[layer])
    return rmsnorm(x, final_g)
```

```cpp
#include <hip/hip_runtime.h>
#include <hip/hip_cooperative_groups.h>
#include <hip/hip_bf16.h>
#include <hip/hip_fp16.h>
#include <cstdio>
#include <cstdint>
#include <cmath>
namespace pg8 {
#define PG8_LAS __attribute__((address_space(3)))
typedef unsigned short bf16_t;
typedef short bf16x8 __attribute__((ext_vector_type(8)));
typedef float f32x4 __attribute__((ext_vector_type(4)));
typedef unsigned u32x4 __attribute__((ext_vector_type(4)));
constexpr int BM = 256, BK = 64, HALF = 128, HTB = HALF * BK * 2  , STAGE_BYTES = 8 * HTB, NXCD = 8, WGM = 8;

__host__ __device__ __forceinline__ int lds_byte(int r, int c) { const int st = (r >> 4) * 2 + (c >> 5), rr = r & 15, cc = c & 31, ob = rr * 64 + cc * 2; return st * 1024 + (ob ^ (((ob >> 9) & 1) << 5)); }
__host__ __device__ __forceinline__ void stage_rc(int b, int& R, int& C) { const int st = b / 1024, sb = b % 1024, swz = sb ^ (((sb >> 9) & 1) << 5); R = (st >> 1) * 16 + swz / 64; C = (st & 1) * 32 + (swz % 64) / 2; }
__host__ __device__ __forceinline__ int perm32(int rho) { const int n = rho >> 4, i = rho & 15; return 8 * (i >> 2) + 4 * n + (i & 3); }

struct Unit { int pm, pn; };
struct Gemm { const bf16_t* A; const bf16_t* Bt; int M, N, K; };

struct StaticOrder {
    int nM, nN, nwg, G, c;
    __host__ __device__ void init(int M, int N, int G_, int c_) { nM = M / BM; nN = N / BM; nwg = nM * nN; G = G_; c = c_; }
    __host__ __device__ bool next(int i, Unit& u) const {
        const long L = (long)i * G + c; if (L >= nwg) return false;
        int wgid = (int)L; { const int q = nwg / NXCD, r = nwg % NXCD, xcd = wgid % NXCD, off = wgid / NXCD; wgid = (xcd < r ? xcd * (q + 1) : r * (q + 1) + (xcd - r) * q) + off; }
        const int nig = WGM * nN, gid = wgid / nig, fm = gid * WGM, gsz = (nM - fm) < WGM ? (nM - fm) : WGM;
        u.pm = fm + ((wgid % nig) % gsz); u.pn = (wgid % nig) / gsz; return true;
    }
    __device__ __forceinline__ void a_ready(const Unit&) const {}
    __device__ __forceinline__ void done(const Unit&) const {}
};


__device__ __forceinline__ unsigned cvt_pk_bf16(float lo, float hi) { unsigned r; asm volatile("v_cvt_pk_bf16_f32 %0, %1, %2" : "=v"(r) : "v"(lo), "v"(hi)); return r; }
typedef unsigned u32x2v __attribute__((ext_vector_type(2)));

__device__ __forceinline__ unsigned dpp_pair(unsigned v) { return (unsigned)__builtin_amdgcn_mov_dpp((int)v, 0xB1, 0xf, 0xf, true); }
template <bool NT = false>
__device__ __forceinline__ void store_row_pair(bf16_t* p_even, size_t ld, const u32x4& w0, const u32x4& w1, bool odd) {
    u32x4 p0, p1, i1, i2;
    p0.x = dpp_pair(w0.x); p0.y = dpp_pair(w0.y); p0.z = dpp_pair(w0.z); p0.w = dpp_pair(w0.w);
    p1.x = dpp_pair(w1.x); p1.y = dpp_pair(w1.y); p1.z = dpp_pair(w1.z); p1.w = dpp_pair(w1.w);
    i1.x = odd ? p1.x : w0.x; i1.y = odd ? p1.y : w0.y; i1.z = odd ? p1.z : w0.z; i1.w = odd ? p1.w : w0.w;
    i2.x = odd ? w1.x : p0.x; i2.y = odd ? w1.y : p0.y; i2.z = odd ? w1.z : p0.z; i2.w = odd ? w1.w : p0.w;
    if constexpr (NT) {
        asm volatile("global_store_dwordx4 %0, %1, off sc1\n\ts_nop 1" :: "v"(p_even), "v"(i1) : "memory");
        asm volatile("global_store_dwordx4 %0, %1, off sc1\n\ts_nop 1" :: "v"(p_even + ld), "v"(i2) : "memory"); }
    else { *(u32x4*)(p_even) = i1; *(u32x4*)(p_even + ld) = i2; }
}

struct EpiZ {
    static constexpr bool PERM = true, AFTER_DRAIN = false, HAS_PF = true;
    bf16_t* Z; int ldz; const float* part; bf16_t* ikf; PG8_LAS float* tab;
    __device__ __forceinline__ void prefetch(const Unit& u, int wid) const {
        unsigned voff; asm volatile("v_mbcnt_lo_u32_b32 %0, -1, 0\n\tv_mbcnt_hi_u32_b32 %0, -1, %0\n\tv_lshlrev_b32 %0, 4, %0" : "=v"(voff));
        const float* src = part + (size_t)u.pm * BM * 16 + wid * 512;
        const unsigned dst = (unsigned)(size_t)tab + (unsigned)wid * 2048u;
#pragma unroll
        for (int i = 0; i < 2; ++i) {
            unsigned keep;
            asm volatile("s_mov_b32 %0, m0\n\ts_mov_b32 m0, %3\n\ts_nop 0\n\tglobal_load_lds_dwordx4 %1, %2\n\ts_mov_b32 m0, %0" : "=&s"(keep) : "v"(voff), "s"(src + i * 256), "s"(dst + i * 1024u) : "memory");
        }
    }
    __device__ __forceinline__ void operator()(const f32x4 (&acc)[2][2][4][2], const Unit& u, int wr, int wc, int fr, int fq) const {
        const int row0 = u.pm * BM + wr * 64 + fr;
        const int col0 = u.pn * BM + wc * 64 + 8 * fq;
        const int odd = fr & 1;
        const PG8_LAS float* t = tab + (wr * 64 + fr) * 16 + 4 * fq;
#pragma unroll
        for (int ai = 0; ai < 2; ++ai)
#pragma unroll
            for (int m = 0; m < 4; ++m) {
                const int row = row0 + ai * HALF + m * 16;
                const f32x4 pq = *(const PG8_LAS f32x4*)(t + (ai * HALF + m * 16) * 16);
                float s = (pq[0] + pq[1]) + (pq[2] + pq[3]);
                s += __shfl_xor(s, 16); s += __shfl_xor(s, 32);
                const float rs = __builtin_amdgcn_rsqf(s * (1.0f / 1024.0f) + 1e-6f);
                u32x4 w[2];
#pragma unroll
                for (int bj = 0; bj < 2; ++bj) {
                    const f32x4 v0 = acc[ai][bj][m][0] * rs, v1 = acc[ai][bj][m][1] * rs;
                    w[bj].x = cvt_pk_bf16(v0[0], v0[1]); w[bj].y = cvt_pk_bf16(v0[2], v0[3]); w[bj].z = cvt_pk_bf16(v1[0], v1[1]); w[bj].w = cvt_pk_bf16(v1[2], v1[3]);
                }
                store_row_pair(Z + (size_t)(row - odd) * ldz + col0 + 32 * odd, (size_t)ldz, w[0], w[1], odd);
                if (wc == 0 && u.pn == 15) *(u32x4*)(ikf + ((size_t)(row >> 5) * 128 + fq * 32 + (row & 31)) * 8) = w[0];
            }
    }
};

struct EpiOut {
    static constexpr bool PERM = true, AFTER_DRAIN = false, HAS_PF = false;
    const float* xin; float* xout; bf16_t* xb; float* part;
    __device__ __forceinline__ void operator()(const f32x4 (&acc)[2][2][4][2], const Unit& u, int wr, int wc, int fr, int fq) const {
        const int col0 = u.pn * BM + wc * 64 + 8 * fq;
        const int rbase = u.pm * BM + wr * 64 + fr;
        if (xin) {
#pragma unroll
            for (int g = 0; g < 8; ++g) {
                const int ai = g >> 2, m = g & 3, row = rbase + ai * HALF + m * 16; const size_t off = (size_t)row * 1024 + col0;
                float ss = 0.f;
#pragma unroll
                for (int bj = 0; bj < 2; ++bj) {
                    const size_t c = off + bj * 32;
                    const f32x4 o0 = *(const f32x4*)(xin + c) + acc[ai][bj][m][0], o1 = *(const f32x4*)(xin + c + 4) + acc[ai][bj][m][1];
                    ss += ((o0[0] * o0[0] + o0[1] * o0[1]) + (o0[2] * o0[2] + o0[3] * o0[3])) + ((o1[0] * o1[0] + o1[1] * o1[1]) + (o1[2] * o1[2] + o1[3] * o1[3]));
                    u32x4 w; w.x = cvt_pk_bf16(o0[0], o0[1]); w.y = cvt_pk_bf16(o0[2], o0[3]); w.z = cvt_pk_bf16(o1[0], o1[1]); w.w = cvt_pk_bf16(o1[2], o1[3]);
                    *(u32x4*)(xb + c) = w;
                }
                ss += __shfl_xor(ss, 16); ss += __shfl_xor(ss, 32);
                if (fq == 0) part[(size_t)row * 16 + u.pn * 4 + wc] = ss;
                if (g & 1) asm volatile("" ::: "memory");
            }
            return;
        }
        u32x4 nx[2];
#pragma unroll
        for (int bj = 0; bj < 2; ++bj) nx[bj] = *(const u32x4*)(xb + (size_t)rbase * 1024 + col0 + bj * 32);
#pragma unroll
        for (int g = 0; g < 8; ++g) {
            const int ai = g >> 2, m = g & 3, row = rbase + ai * HALF + m * 16; const size_t off = (size_t)row * 1024 + col0;
            u32x4 cur[2] = {nx[0], nx[1]};
            if (g < 7) { const int g1 = g + 1, row1 = rbase + (g1 >> 2) * HALF + (g1 & 3) * 16;
#pragma unroll
                for (int bj = 0; bj < 2; ++bj) nx[bj] = *(const u32x4*)(xb + (size_t)row1 * 1024 + col0 + bj * 32); }
            float ss = 0.f; u32x4 w[2];
#pragma unroll
            for (int bj = 0; bj < 2; ++bj) {
                const size_t c = off + bj * 32; const u32x4 rb = cur[bj];
                const f32x4 x0 = (f32x4){__uint_as_float(rb.x << 16), __uint_as_float(rb.x & 0xffff0000u), __uint_as_float(rb.y << 16), __uint_as_float(rb.y & 0xffff0000u)};
                const f32x4 x1 = (f32x4){__uint_as_float(rb.z << 16), __uint_as_float(rb.z & 0xffff0000u), __uint_as_float(rb.w << 16), __uint_as_float(rb.w & 0xffff0000u)};
                const f32x4 o0 = x0 + acc[ai][bj][m][0], o1 = x1 + acc[ai][bj][m][1];
                if (xout) { *(f32x4*)(xout + c) = o0; *(f32x4*)(xout + c + 4) = o1; }
                ss += ((o0[0] * o0[0] + o0[1] * o0[1]) + (o0[2] * o0[2] + o0[3] * o0[3])) + ((o1[0] * o1[0] + o1[1] * o1[1]) + (o1[2] * o1[2] + o1[3] * o1[3]));
                w[bj].x = cvt_pk_bf16(o0[0], o0[1]); w[bj].y = cvt_pk_bf16(o0[2], o0[3]); w[bj].z = cvt_pk_bf16(o1[0], o1[1]); w[bj].w = cvt_pk_bf16(o1[2], o1[3]);
            }
            { const int odd = fr & 1; store_row_pair(xb + (size_t)(row - odd) * 1024 + col0 + 32 * odd, (size_t)1024, w[0], w[1], odd); }
            ss += __shfl_xor(ss, 16); ss += __shfl_xor(ss, 32);
            if (fq == 0) part[(size_t)row * 16 + u.pn * 4 + wc] = ss;
        }
    }
};

template <class Epi, class Sched, bool ALIGN_EPI = false, bool SP2 = false>
__device__ __forceinline__ void gemm_phase(PG8_LAS unsigned char* lds, const Gemm g, const Sched& S, const Epi& E, int tid_in) {
    int tid0_ = tid_in; asm volatile("" : "+v"(tid0_));
    const int tid = tid0_, wid = __builtin_amdgcn_readfirstlane(tid >> 6), lane = tid & 63, wr = wid >> 2, wc = wid & 3, fr = lane & 15, fq = lane >> 4;
    const int K = g.K, nt = K / BK;
    unsigned voffA[2], voffB[2];
#pragma unroll
    for (int i = 0; i < 2; ++i) { int R, C; stage_rc(tid * 16 + i * 8192, R, C); const int Rb = Epi::PERM ? ((R & ~31) + perm32(R & 31)) : R;
        voffA[i] = (unsigned)(R * K + C) * 2u; voffB[i] = (unsigned)((64 * (Rb >> 5) + (Rb & 31)) * K + C) * 2u; }
    const size_t kstep = (size_t)(BK * 2);
    const size_t hstep = (size_t)HALF * K * 2;
    const size_t hstepB = (size_t)32 * K * 2;
    const size_t tstep = 2 * hstep;
    const unsigned ldsw = (unsigned)wid * 1024u;
    const int aoff = lds_byte(wr * 64 + fr, fq * 8), boff = lds_byte(wc * 32 + fr, fq * 8);
#define PG8_SA(b, h) (((b) * 2 + (h)) * HTB)
#define PG8_SB(b, h) ((4 + (b) * 2 + (h)) * HTB)
#define PG8_STAGE(bufoff, gbase, voff) do { _Pragma("unroll") for (int _i = 0; _i < 2; ++_i) \
        __builtin_amdgcn_global_load_lds((const unsigned*)((const char*)(gbase) + (voff)[_i]), (PG8_LAS unsigned*)(lds + (bufoff) + ldsw + _i * 8192), 16, 0, 0); } while (0)
#define PG8_LDA(dst, b, h) do { _Pragma("unroll") for (int m = 0; m < 4; ++m) _Pragma("unroll") for (int k = 0; k < 2; ++k) dst[m][k] = *(const PG8_LAS bf16x8*)(lds + PG8_SA(b, h) + aoff + m * 2048 + k * 1024); } while (0)
#define PG8_LDB(dst, b, h) do { _Pragma("unroll") for (int n = 0; n < 2; ++n) _Pragma("unroll") for (int k = 0; k < 2; ++k) dst[n][k] = *(const PG8_LAS bf16x8*)(lds + PG8_SB(b, h) + boff + n * 2048 + k * 1024); } while (0)
#define PG8_MMA(ai, bj, At, Bt) do { __builtin_amdgcn_s_setprio(1); _Pragma("unroll") for (int m = 0; m < 4; ++m) _Pragma("unroll") for (int n = 0; n < 2; ++n) _Pragma("unroll") for (int k = 0; k < 2; ++k) \
        acc[ai][bj][m][n] = __builtin_amdgcn_mfma_f32_16x16x32_bf16(Bt[n][k], At[m][k], acc[ai][bj][m][n], 0, 0, 0); __builtin_amdgcn_s_setprio(0); } while (0)
#define PG8_WAIT_V(n) asm volatile("s_waitcnt vmcnt(" #n ")" ::: "memory")
#define PG8_WAIT_L(n) asm volatile("s_waitcnt lgkmcnt(" #n ")" ::: "memory")
#define PG8_BAR __builtin_amdgcn_s_barrier()
#define PG8_SCHED __builtin_amdgcn_sched_barrier(0)
    Unit cur, nxt; int ui = 0;
    if (!S.next(0, cur)) return;
    f32x4 acc[2][2][4][2];
#pragma unroll
    for (int a = 0; a < 2; ++a)
#pragma unroll
        for (int b = 0; b < 2; ++b)
#pragma unroll
            for (int m = 0; m < 4; ++m)
#pragma unroll
                for (int n = 0; n < 2; ++n) acc[a][b][m][n] = (f32x4){0.f, 0.f, 0.f, 0.f};
    bf16x8 At[4][2], B0[2][2], B1[2][2];
    const char* cA = (const char*)g.A + (size_t)cur.pm * tstep; const char* cB = (const char*)g.Bt + (size_t)cur.pn * tstep;
    S.a_ready(cur);
    if constexpr (SP2) {
        PG8_STAGE(PG8_SB(0, 0), cB, voffB); PG8_STAGE(PG8_SB(0, 1), cB + hstepB, voffB); PG8_STAGE(PG8_SA(0, 0), cA, voffA); PG8_STAGE(PG8_SA(0, 1), cA + hstep, voffA);
        if (wr == 1) PG8_BAR;
        PG8_WAIT_V(2); PG8_BAR;
        PG8_STAGE(PG8_SB(1, 0), cB + kstep, voffB); PG8_STAGE(PG8_SA(1, 0), cA + kstep, voffA); PG8_STAGE(PG8_SB(1, 1), cB + hstepB + kstep, voffB);
        PG8_WAIT_V(6); PG8_BAR;
    } else {
        PG8_STAGE(PG8_SB(0, 0), cB, voffB); PG8_STAGE(PG8_SA(0, 0), cA, voffA); PG8_STAGE(PG8_SB(0, 1), cB + hstepB, voffB); PG8_STAGE(PG8_SA(0, 1), cA + hstep, voffA);
        if (wr == 1) PG8_BAR;
        PG8_WAIT_V(4); PG8_BAR;
        PG8_STAGE(PG8_SB(1, 0), cB + kstep, voffB); PG8_STAGE(PG8_SA(1, 0), cA + kstep, voffA); PG8_STAGE(PG8_SB(1, 1), cB + hstepB + kstep, voffB);
        PG8_WAIT_V(6); PG8_BAR;
    }
    for (;;) {
        const bool has_next = S.next(ui + 1, nxt);
        const char* nA = has_next ? (const char*)g.A + (size_t)nxt.pm * tstep : cA; const char* nB = has_next ? (const char*)g.Bt + (size_t)nxt.pn * tstep : cB;
        for (int t = 0; t < nt; t += 2) {
            const bool last = (t == nt - 2);
            const char* a1 = cA + (size_t)(t + 1) * kstep;
            const char* a2 = last ? nA : cA + (size_t)(t + 2) * kstep; const char* b2 = last ? nB : cB + (size_t)(t + 2) * kstep;
            const char* a3 = a2 + kstep; const char* b3 = b2 + kstep;
            if (last && has_next) S.a_ready(nxt);
            if constexpr (SP2) {
            PG8_LDB(B0, 0, 0); PG8_LDB(B1, 0, 1); PG8_SCHED; PG8_LDA(At, 0, 0); PG8_STAGE(PG8_SA(1, 1), a1 + hstep, voffA);
            PG8_WAIT_V(8); PG8_WAIT_L(0); PG8_BAR; PG8_MMA(0, 0, At, B0); PG8_MMA(0, 1, At, B1); PG8_BAR; PG8_SCHED;
            PG8_LDA(At, 0, 1); PG8_STAGE(PG8_SB(0, 0), b2, voffB); PG8_STAGE(PG8_SB(0, 1), b2 + hstepB, voffB); PG8_STAGE(PG8_SA(0, 0), a2, voffA);
            PG8_WAIT_V(8); PG8_WAIT_L(0); PG8_BAR; PG8_MMA(1, 0, At, B0); PG8_MMA(1, 1, At, B1); PG8_BAR; PG8_SCHED;
            PG8_LDB(B0, 1, 0); PG8_LDB(B1, 1, 1); PG8_SCHED; PG8_LDA(At, 1, 0); PG8_STAGE(PG8_SA(0, 1), a2 + hstep, voffA);
            PG8_WAIT_V(8); PG8_WAIT_L(0); PG8_BAR; PG8_MMA(0, 0, At, B0); PG8_MMA(0, 1, At, B1); PG8_BAR; PG8_SCHED;
            PG8_LDA(At, 1, 1); PG8_STAGE(PG8_SB(1, 0), b3, voffB); PG8_STAGE(PG8_SB(1, 1), b3 + hstepB, voffB); PG8_STAGE(PG8_SA(1, 0), a3, voffA);
            PG8_WAIT_V(8); PG8_WAIT_L(0); PG8_BAR; PG8_MMA(1, 0, At, B0); PG8_MMA(1, 1, At, B1); PG8_BAR; PG8_SCHED;
            if constexpr (Epi::HAS_PF) { if (t == 4) E.prefetch(cur, wid); }
            } else {
            PG8_LDB(B0, 0, 0); PG8_SCHED; PG8_LDA(At, 0, 0); PG8_STAGE(PG8_SA(1, 1), a1 + hstep, voffA);
            PG8_WAIT_L(8); PG8_BAR; PG8_WAIT_L(0); PG8_MMA(0, 0, At, B0); PG8_BAR; PG8_SCHED;
            PG8_LDB(B1, 0, 1); PG8_STAGE(PG8_SB(0, 0), b2, voffB);
            PG8_BAR; PG8_WAIT_L(0); PG8_MMA(0, 1, At, B1); PG8_BAR;
            PG8_LDA(At, 0, 1); PG8_STAGE(PG8_SA(0, 0), a2, voffA);
            PG8_BAR; PG8_WAIT_L(0); PG8_MMA(1, 0, At, B0); PG8_BAR; PG8_SCHED;
            PG8_STAGE(PG8_SB(0, 1), b2 + hstepB, voffB);
            PG8_WAIT_V(6); PG8_BAR; PG8_MMA(1, 1, At, B1); PG8_BAR;
            PG8_LDB(B0, 1, 0); PG8_SCHED; PG8_LDA(At, 1, 0); PG8_STAGE(PG8_SA(0, 1), a2 + hstep, voffA);
            PG8_WAIT_L(8); PG8_BAR; PG8_WAIT_L(0); PG8_MMA(0, 0, At, B0); PG8_BAR; PG8_SCHED;
            PG8_LDB(B1, 1, 1); PG8_STAGE(PG8_SB(1, 0), b3, voffB);
            PG8_BAR; PG8_WAIT_L(0); PG8_MMA(0, 1, At, B1); PG8_BAR;
            PG8_LDA(At, 1, 1); PG8_STAGE(PG8_SA(1, 0), a3, voffA);
            PG8_BAR; PG8_WAIT_L(0); PG8_MMA(1, 0, At, B0); PG8_BAR; PG8_SCHED;
            PG8_STAGE(PG8_SB(1, 1), b3 + hstepB, voffB);
            PG8_WAIT_V(6); PG8_BAR; PG8_MMA(1, 1, At, B1); PG8_BAR;
            }
        }
        if constexpr (ALIGN_EPI) { if (wr == 0) PG8_BAR; }
        if constexpr (!Epi::AFTER_DRAIN) { E(acc, cur, wr, wc, fr, fq); S.done(cur); }
        if (!has_next) break;
#pragma unroll
        for (int a = 0; a < 2; ++a)
#pragma unroll
            for (int b = 0; b < 2; ++b)
#pragma unroll
                for (int m = 0; m < 4; ++m)
#pragma unroll
                    for (int n = 0; n < 2; ++n) acc[a][b][m][n] = (f32x4){0.f, 0.f, 0.f, 0.f};
        cur = nxt; cA = nA; cB = nB; ++ui;
        if constexpr (ALIGN_EPI) { if (wr == 1) PG8_BAR; }
    }
    PG8_WAIT_V(0);
    if constexpr (!ALIGN_EPI) { if (wr == 0) PG8_BAR; }
    PG8_BAR;
    if constexpr (Epi::AFTER_DRAIN) { E.fused(acc, cur, wr, wc, fr, fq, lds, wid, lane); S.done(cur); }
#undef PG8_SA
#undef PG8_SB
#undef PG8_STAGE
#undef PG8_LDA
#undef PG8_LDB
#undef PG8_MMA
#undef PG8_WAIT_V
#undef PG8_WAIT_L
#undef PG8_BAR
#undef PG8_SCHED
}
}

#ifndef PG8_SP2
#define PG8_SP2 true
#endif
#ifndef PG8_ALIGN
#define PG8_ALIGN true
#endif
#ifndef MK_FUSED
#define MK_FUSED 1
#endif

namespace cg = cooperative_groups;
#define GAS __attribute__((address_space(1)))
#define LAS __attribute__((address_space(3)))
typedef unsigned short bf16;
typedef float f32x4 __attribute__((ext_vector_type(4)));
typedef float f32x16 __attribute__((ext_vector_type(16)));
typedef short bf16x8 __attribute__((ext_vector_type(8)));
typedef short s16x4 __attribute__((ext_vector_type(4)));
typedef unsigned u32x4 __attribute__((ext_vector_type(4)));
typedef unsigned u32x2 __attribute__((ext_vector_type(2)));
typedef float f32x2_p __attribute__((ext_vector_type(2)));

constexpr int NB = 16, SEQ = 2048, DM = 1024, MTOK = NB * SEQ, NZ = 4096, DEPTH = 4, NIN = 3886;
constexpr int NH = 6, HD = 64;
constexpr int C_PV = 0, C_PG = 256, C_DQ = 512, C_DK = 896, C_DV = 1280, C_DG = 1664, C_IQ = 2048, C_FQ = 2304, C_FK = 2688, C_FV = 3072, C_FG = 3456, C_IK = 3840, C_IW = 3872, C_FF = 3880;
constexpr float LOG2E = 1.4426950408889634f;
constexpr float C2 = 0.125f * LOG2E;
constexpr int NWAVES = 8, NTHREADS = 512;

constexpr size_t MiB = 1u << 20;
constexpr size_t WS_CTL = 0, CTL_ZERO_BYTES = 1 * MiB;
constexpr size_t WS_WIN = 2 * MiB;
constexpr size_t WS_WOUT = 34 * MiB;
constexpr size_t WS_PW = 42 * MiB;
constexpr size_t WS_F2 = 43 * MiB;
constexpr size_t WS_PART = 44 * MiB;
constexpr size_t WS_MASK = 46 * MiB;
constexpr size_t WS_XB = 78 * MiB;
constexpr size_t WS_MIX = 142 * MiB;
constexpr size_t WS_Z = 206 * MiB;
constexpr size_t WS_IKF = 462 * MiB;
constexpr size_t WS_KA = 464 * MiB;
constexpr size_t WS_END = 472 * MiB;
constexpr int CW_BAR = 4096;

constexpr int LDS_LUT = 149504;
constexpr int LDS_BYTES = 149504 + 256 + 256;

__device__ __forceinline__ unsigned f2bf(float f) { unsigned u = __builtin_bit_cast(unsigned, f); return (u + 0x7fffu + ((u >> 16) & 1u)) >> 16; }
typedef float f32x2_t __attribute__((ext_vector_type(2))); typedef __bf16 bf16x2_t __attribute__((ext_vector_type(2)));
__device__ __forceinline__ unsigned cvtpk_s(float lo, float hi) { f32x2_t v = {lo, hi}; bf16x2_t b = __builtin_convertvector(v, bf16x2_t); return __builtin_bit_cast(unsigned, b); }
__device__ __forceinline__ unsigned pk2(float lo, float hi) { return cvtpk_s(lo, hi); }
__device__ __forceinline__ float bf2f(unsigned short b) { return __builtin_bit_cast(float, (unsigned)b << 16); }
__device__ __forceinline__ float bflo(unsigned w) { return __builtin_bit_cast(float, w << 16); }
__device__ __forceinline__ float bfhi(unsigned w) { return __builtin_bit_cast(float, w & 0xffff0000u); }
__device__ __forceinline__ float wave_sum(float v) {
#pragma unroll
    for (int o = 1; o < 64; o <<= 1) v += __shfl_xor(v, o);
    return v;
}
__device__ __forceinline__ float silu_f(float g) { return g * __builtin_amdgcn_rcpf(1.0f + __expf(-g)); }
__device__ __forceinline__ int crow(int r, int hi) { return (r & 3) + 8 * (r >> 2) + 4 * hi; }

struct Frame {
    LAS unsigned char* lds; char* ldsg;
    int tid, lane, wave, G, bid;
};

__device__ __forceinline__ int orig_col(int n) {
    if (n < 2304) return n;
    if (n < 3840) return n + 40;
    if (n < 3872) return 2304 + (n - 3840);
    if (n < 3880) return 2336 + (n - 3872);
    if (n < 3886) return n;
    return -1;
}
template <bool IN>
__device__ __forceinline__ void p0_transpose_item(const float* W, int ldw, const float* g, bf16* WT, LAS float* scr, int item, int nblk, int lane) {
    const int kb = item / nblk, nb = item % nblk, k0 = 64 * kb, n0 = 32 * nb;
    if (IN && n0 >= 3872) {
        const int n = n0 + (lane & 31); const int oc = orig_col(n);
#pragma unroll 8
        for (int i = 0; i < 32; ++i) {
            const int kk = 2 * i + (lane >> 5);
            float v = 0.f;
            if (oc >= 0) v = W[(size_t)(k0 + kk) * ldw + oc] * g[k0 + kk];
            scr[kk * 33 + (lane & 31)] = v;
        }
    } else if (IN) {
        const int oc0 = orig_col(n0), c2 = 2 * (lane & 15), rr = lane >> 4;
        const float cs = ((n0 >= C_DQ && n0 < C_DK) || (n0 >= C_FQ && n0 < C_FK)) ? C2 : 1.f;
#pragma unroll 8
        for (int i = 0; i < 16; ++i) {
            const int kk = 4 * i + rr;
            const f32x2_p v = *(const f32x2_p*)(W + (size_t)(k0 + kk) * ldw + oc0 + c2);
            const float gs = g[k0 + kk] * cs;
            scr[kk * 33 + c2] = v[0] * gs; scr[kk * 33 + c2 + 1] = v[1] * gs;
        }
    } else {
        const int c4 = 4 * (lane & 7), rr = lane >> 3;
#pragma unroll
        for (int i = 0; i < 8; ++i) {
            const int kk = 8 * i + rr;
            const f32x4 v = *(const f32x4*)(W + (size_t)(k0 + kk) * ldw + n0 + c4);
            scr[kk * 33 + c4] = v[0]; scr[kk * 33 + c4 + 1] = v[1]; scr[kk * 33 + c4 + 2] = v[2]; scr[kk * 33 + c4 + 3] = v[3];
        }
    }
    asm volatile("s_waitcnt lgkmcnt(0)" ::: "memory");
    const int c = lane & 7;
#pragma unroll
    for (int j = 0; j < 4; ++j) {
        const int nn = (lane >> 3) + 8 * j; const LAS float* s = scr + (8 * c) * 33 + nn;
        u32x4 o; o.x = pk2(s[0 * 33], s[1 * 33]); o.y = pk2(s[2 * 33], s[3 * 33]); o.z = pk2(s[4 * 33], s[5 * 33]); o.w = pk2(s[6 * 33], s[7 * 33]);
        *(u32x4*)(WT + (size_t)(n0 + nn) * 1024 + k0 + 8 * c) = o;
    }
    asm volatile("s_waitcnt lgkmcnt(0)" ::: "memory");
}

__device__ __forceinline__ void p0_prep(Frame& F, const float* x, const float* w_in, const float* norm_g, const float* pool_w, const float* w_out, unsigned char* ws) {
    LAS float* scr = (LAS float*)(F.lds + F.wave * 16384);
    const int gw = F.bid * NWAVES + F.wave, NGW = F.G * NWAVES;
    constexpr int I_IN = 16 * 128, I_OUT = 16 * 32, I_L = I_IN + I_OUT;
    {
        bf16* pwt = (bf16*)(ws + WS_PW);
        for (int i = F.bid * NTHREADS + F.tid; i < DEPTH * 4 * 64 * 64; i += F.G * NTHREADS) {
            const int c = i & 63, d = (i >> 6) & 63, lg = i >> 12;
            pwt[i] = (bf16)f2bf(pool_w[(size_t)lg * 4096 + c * 64 + d]);
        }
    }
    bf16* xb = (bf16*)(ws + WS_XB); float* part = (float*)(ws + WS_PART);
    int it = gw;
    for (int m0 = gw; m0 < MTOK || it < DEPTH * I_L; m0 += 4 * NGW, it += NGW) {
        f32x4 v[4][4]; float s[4];
#pragma unroll
        for (int r = 0; r < 4; ++r) { const int m = m0 + r * NGW; if (m < MTOK) { const f32x4* xr = (const f32x4*)(x + (size_t)m * DM) + F.lane;
#pragma unroll
            for (int j = 0; j < 4; ++j) v[r][j] = xr[64 * j]; } }
        if (it < DEPTH * I_L) {
            const int l = it / I_L, r = it % I_L;
            if (r < I_IN) p0_transpose_item<true>(w_in + (size_t)l * 1024 * NIN, NIN, norm_g + l * 1024, (bf16*)(ws + WS_WIN) + (size_t)l * NZ * 1024, scr, r, 128, F.lane);
            else p0_transpose_item<false>(w_out + (size_t)l * 1024 * 1024, 1024, nullptr, (bf16*)(ws + WS_WOUT) + (size_t)l * 1024 * 1024, scr, r - I_IN, 32, F.lane);
        }
#pragma unroll
        for (int r = 0; r < 4; ++r) { const int m = m0 + r * NGW; if (m < MTOK) { float t = 0.f;
#pragma unroll
            for (int j = 0; j < 4; ++j) t += (v[r][j][0] * v[r][j][0] + v[r][j][1] * v[r][j][1]) + (v[r][j][2] * v[r][j][2] + v[r][j][3] * v[r][j][3]);
            s[r] = wave_sum(t);
            unsigned long long* o8 = (unsigned long long*)(xb + (size_t)m * DM) + F.lane;
#pragma unroll
            for (int j = 0; j < 4; ++j) o8[64 * j] = (unsigned long long)pk2(v[r][j][0], v[r][j][1]) | ((unsigned long long)pk2(v[r][j][2], v[r][j][3]) << 32);
            if (F.lane < 16) part[(size_t)m * 16 + F.lane] = (F.lane == 0) ? s[r] : 0.f; } }
    }
}

__device__ __forceinline__ void scan_phase(Frame& F, const bf16* Z, const float* fox_bf  , float* F2) {
    LAS float* wtot = (LAS float*)F.lds;
    for (int vb = F.bid; vb < 256; vb += F.G) {
        if (vb < 32 || vb >= 64) continue;
        const int b = (vb - 32) & 15, h0 = 3 * ((vb - 32) >> 4);
        float cum[4][3];
        float run[3] = {0.f, 0.f, 0.f};
        const float bf0 = fox_bf[h0], bf1 = fox_bf[h0 + 1], bf2 = fox_bf[h0 + 2];
#pragma unroll
        for (int j = 0; j < 4; ++j) {
            const int t = 4 * F.tid + j;
            const u32x4 w = *(const u32x4*)(Z + (size_t)(b * SEQ + t) * NZ + C_FF);
            const float ff[6] = {bflo(w.x), bfhi(w.x), bflo(w.y), bfhi(w.y), bflo(w.z), bfhi(w.z)};
            const float x3[3] = {(h0 ? ff[3] : ff[0]) + bf0, (h0 ? ff[4] : ff[1]) + bf1, (h0 ? ff[5] : ff[2]) + bf2};
#pragma unroll
            for (int h = 0; h < 3; ++h) {
                const float xx = x3[h];
                const float ls = fminf(xx, 0.f) - __logf(1.0f + __expf(-fabsf(xx)));
                run[h] += ls * LOG2E; cum[j][h] = run[h];
            }
        }
        float pre[3];
#pragma unroll
        for (int h = 0; h < 3; ++h) {
            float v = run[h];
#pragma unroll
            for (int o = 1; o < 64; o <<= 1) { const float n = __shfl_up(v, o); if (F.lane >= o) v += n; }
            pre[h] = v - run[h];
            if (F.lane == 63) wtot[F.wave * 4 + h] = v;
        }
        __syncthreads();
#pragma unroll
        for (int h = 0; h < 3; ++h) {
            float off = 0.f;
            for (int w = 0; w < F.wave; ++w) off += wtot[w * 4 + h];
            pre[h] += off;
        }
#pragma unroll
        for (int h = 0; h < 3; ++h) {
            f32x4 o = {cum[0][h] + pre[h], cum[1][h] + pre[h], cum[2][h] + pre[h], cum[3][h] + pre[h]};
            *(f32x4*)(F2 + ((size_t)(b * NH + h0 + h) * SEQ + 4 * F.tid)) = o;
            u32x4* ka = (u32x4*)((char*)F2 + (WS_KA - WS_F2)) + ((size_t)(b * NH + h0 + h) * SEQ + 4 * F.tid) * 2;
#pragma unroll
            for (int j = 0; j < 4; ++j) { const float x = o[j]; const unsigned b0 = __float_as_uint(x) & 0xffff0000u; const float r1 = x - __uint_as_float(b0);
                const unsigned b1 = __float_as_uint(r1) & 0xffff0000u; const float r2 = r1 - __uint_as_float(b1); const unsigned b2 = __float_as_uint(r2) & 0xffff0000u;
                ka[2 * j] = (u32x4){(b0 >> 16) | b1, (b2 >> 16) | 0x3f800000u, 0x3f803f80u, 0u}; ka[2 * j + 1] = (u32x4){0u, 0u, 0u, 0u}; }
        }
        __syncthreads();
    }
}

__device__ __forceinline__ void pool_phase(Frame& F, const bf16* Z, const bf16* pwt  , const float* pscale  , bf16* mixed) {
    constexpr int VROWS = 79, VPITCH = 512, PPITCH = 528;
    LAS unsigned char* Vt = F.lds;
    LAS unsigned char* Pt = F.lds + 40960;
    const int lane = F.lane, hi = lane >> 5, r32 = lane & 31;
    const int gi = F.wave & 3, th = F.wave >> 2;
    bf16x8 bw[2][4];
#pragma unroll
    for (int ct = 0; ct < 2; ++ct)
#pragma unroll
        for (int s = 0; s < 4; ++s) bw[ct][s] = *(const bf16x8*)(pwt + (size_t)gi * 4096 + (ct * 32 + r32) * 64 + 16 * s + 8 * hi);
    u32x4 vpre[5];
#define POOL_FETCH(it_) do { const int b_ = (it_) >> 5, t0_ = ((it_) & 31) * 64; _Pragma("unroll") for (int i5 = 0; i5 < 5; ++i5) { const int i = F.tid + i5 * NTHREADS; \
        const int r = i >> 5, ch = i & 31, t = t0_ - 15 + r; vpre[i5] = (u32x4){0u, 0u, 0u, 0u}; \
        if (i < VROWS * 32 && t >= 0) vpre[i5] = *(const u32x4*)(Z + (size_t)(b_ * SEQ + t) * NZ + C_PV + ch * 8); } } while (0)
    if (F.bid < NB * 32) POOL_FETCH(F.bid);
    for (int it = F.bid; it < NB * 32; it += F.G) {
        const int b = it >> 5, t0 = (it & 31) * 64;
        u32x4 gpre[4];
#pragma unroll
        for (int i = 0; i < 4; ++i) { const int idx = F.tid + i * NTHREADS, tok = idx >> 5, ch = idx & 31; gpre[i] = *(const u32x4*)(Z + ((size_t)b * SEQ + t0 + tok) * NZ + C_PG + ch * 8); }
        __syncthreads();
#pragma unroll
        for (int i5 = 0; i5 < 5; ++i5) { const int i = F.tid + i5 * NTHREADS; const int r = i >> 5, ch = i & 31; if (i < VROWS * 32) *(LAS u32x4*)(Vt + r * VPITCH + ch * 16) = vpre[i5]; }
        if (it + F.G < NB * 32) POOL_FETCH(it + F.G);
        __syncthreads();
        {
            const int cp = F.tid & 127, tr = F.tid >> 7, g = cp >> 5, w = 2 << g;
            float s0 = 0.f, s1 = 0.f;
            const int rbase = 15 + 16 * tr;
            unsigned hv[15];
#pragma unroll
            for (int j = 1; j <= 15; ++j) hv[j - 1] = *(LAS unsigned*)(Vt + (rbase - j) * VPITCH + cp * 4);
            unsigned cv[16];
#pragma unroll
            for (int k = 0; k < 16; ++k) cv[k] = *(LAS unsigned*)(Vt + (rbase + k) * VPITCH + cp * 4);
            unsigned ov[16];
#pragma unroll
            for (int k = 0; k < 16; ++k) ov[k] = *(LAS unsigned*)(Vt + (rbase + k - w + 1) * VPITCH + cp * 4);
#pragma unroll
            for (int j = 1; j <= 15; ++j) if (j < w) { s0 += bflo(hv[j - 1]); s1 += bfhi(hv[j - 1]); }
#pragma unroll
            for (int k = 0; k < 16; ++k) {
                const int t = t0 + 16 * tr + k;
                const float v0 = bflo(cv[k]), v1 = bfhi(cv[k]);
                s0 += v0; s1 += v1;
                const float rc = __builtin_amdgcn_rcpf((float)((t + 1 < w) ? (t + 1) : w));
                const float p0 = s0 * rc - v0, p1 = s1 * rc - v1;
                *(LAS unsigned*)(Pt + (16 * tr + k) * PPITCH + cp * 4) = pk2(p0, p1);
                const unsigned vo = ov[k];
                s0 -= bflo(vo); s1 -= bfhi(vo);
            }
        }
        __syncthreads();
        f32x16 acc[2];
#pragma unroll
        for (int ct = 0; ct < 2; ++ct) acc[ct] = f32x16{};
#pragma unroll
        for (int s = 0; s < 4; ++s) {
            const bf16x8 a = *(LAS bf16x8*)(Pt + (th * 32 + r32) * PPITCH + (gi * 64 + 16 * s + 8 * hi) * 2);
#pragma unroll
            for (int ct = 0; ct < 2; ++ct) acc[ct] = __builtin_amdgcn_mfma_f32_32x32x16_bf16(a, bw[ct][s], acc[ct], 0, 0, 0);
        }
        {
            LAS float* Yt = (LAS float*)(F.lds + 81920);
#pragma unroll
            for (int ct = 0; ct < 2; ++ct)
#pragma unroll
                for (int r = 0; r < 16; ++r) Yt[(th * 32 + crow(r, hi)) * 260 + gi * 64 + ct * 32 + r32] = acc[ct][r];
            __syncthreads();
#pragma unroll
            for (int i = 0; i < 4; ++i) {
                const int idx = F.tid + i * NTHREADS, tok = idx >> 5, ch = idx & 31;
                const size_t row = (size_t)b * SEQ + t0 + tok;
                const f32x4 y0 = *(const LAS f32x4*)(Yt + tok * 260 + ch * 8), y1 = *(const LAS f32x4*)(Yt + tok * 260 + ch * 8 + 4);
                const f32x4 s0 = *(const f32x4*)(pscale + ch * 8), s1 = *(const f32x4*)(pscale + ch * 8 + 4);
                const u32x4 g = gpre[i];
                u32x4 o;
                o.x = pk2(y0[0] * s0[0] * silu_f(bflo(g.x)), y0[1] * s0[1] * silu_f(bfhi(g.x)));
                o.y = pk2(y0[2] * s0[2] * silu_f(bflo(g.y)), y0[3] * s0[3] * silu_f(bfhi(g.y)));
                o.z = pk2(y1[0] * s1[0] * silu_f(bflo(g.z)), y1[1] * s1[1] * silu_f(bfhi(g.z)));
                o.w = pk2(y1[2] * s1[2] * silu_f(bflo(g.w)), y1[3] * s1[3] * silu_f(bfhi(g.w)));
                *(u32x4*)(mixed + row * DM + ch * 8) = o;
            }
        }
    }
#undef POOL_FETCH
    __syncthreads();
}

__device__ __forceinline__ unsigned key16(float s) {
    const unsigned bits = (unsigned)__half_as_ushort(__float2half_rn(s));
    return (bits & 0x8000u) ? (~bits & 0xffffu) : (bits | 0x8000u);
}
__device__ __forceinline__ float relu_i(float x) { const int i = __float_as_int(x); return __int_as_float(i > 0 ? i : 0); }
typedef short s16x2 __attribute__((ext_vector_type(2)));
typedef _Float16 h16x2 __attribute__((ext_vector_type(2)));
__device__ __forceinline__ unsigned key16x2(float s0, float s1) {
    const h16x2 hh = {(_Float16)s0, (_Float16)s1};
    const s16x2 p = __builtin_bit_cast(s16x2, hh);
    const s16x2 m = p >> (short)15;
    const unsigned pu = __builtin_bit_cast(unsigned, p), mu = __builtin_bit_cast(unsigned, m);
    return pu ^ (mu | 0x80008000u);
}
__device__ __forceinline__ void hist_find(const LAS unsigned* hrow, unsigned need, int lane, unsigned& bin, unsigned& above) {
    const u32x4 c4 = *(const LAS u32x4*)(hrow + 4 * lane);
    const unsigned s4 = (c4.x + c4.y) + (c4.z + c4.w);
    unsigned S = s4;
#pragma unroll
    for (int o = 1; o < 64; o <<= 1) { const unsigned n = __shfl_down(S, o); if (lane + o < 64) S += n; }
    const unsigned Sn = S - s4;
    const bool found = (S >= need) && (Sn < need);
    unsigned mybin = 0, myab = 0;
    {
        unsigned ab = Sn; bool done = false;
        const unsigned cc[4] = {c4.x, c4.y, c4.z, c4.w};
#pragma unroll
        for (int j = 3; j >= 0; --j) { if (!done && ab + cc[j] >= need) { mybin = 4 * lane + j; myab = ab; done = true; } if (!done) ab += cc[j]; }
    }
    const unsigned long long bal = __ballot(found);
    const int src = bal ? (int)__builtin_ctzll(bal) : 0;
    bin = __shfl(mybin, src); above = __shfl(myab, src);
}

__device__ __forceinline__ void hist_find_pk(const LAS unsigned* hrow, int shift, unsigned need, int lane, unsigned& bin, unsigned& above) {
    const u32x4 c4 = *(const LAS u32x4*)(hrow + 4 * lane);
    const unsigned cc[4] = {(c4.x >> shift) & 0xffffu, (c4.y >> shift) & 0xffffu, (c4.z >> shift) & 0xffffu, (c4.w >> shift) & 0xffffu};
    const unsigned s4 = (cc[0] + cc[1]) + (cc[2] + cc[3]);
    unsigned S = s4;
#pragma unroll
    for (int o = 1; o < 64; o <<= 1) { const unsigned n = __shfl_down(S, o); if (lane + o < 64) S += n; }
    const unsigned Sn = S - s4;
    const bool found = (S >= need) && (Sn < need);
    unsigned mybin = 0, myab = 0;
    {
        unsigned ab = Sn; bool done = false;
#pragma unroll
        for (int j = 3; j >= 0; --j) { if (!done && ab + cc[j] >= need) { mybin = 4 * lane + j; myab = ab; done = true; } if (!done) ab += cc[j]; }
    }
    const unsigned long long bal = __ballot(found);
    const int src = bal ? (int)__builtin_ctzll(bal) : 0;
    bin = __shfl(mybin, src); above = __shfl(myab, src);
}

__device__ __forceinline__ void hist_find4(const LAS unsigned* hist, unsigned need0, unsigned need1, int lane, unsigned& bin0, unsigned& above0, unsigned& bin1, unsigned& above1) {
    const int hi = lane >> 5, n32 = lane & 31;
    const LAS unsigned* hr = hist + hi * 256 + 8 * n32;
    const u32x4 ca = *(const LAS u32x4*)(hr), cb = *(const LAS u32x4*)(hr + 4);
    const unsigned cc[8] = {ca.x, ca.y, ca.z, ca.w, cb.x, cb.y, cb.z, cb.w};
    const unsigned s8 = ((cc[0] + cc[1]) + (cc[2] + cc[3])) + ((cc[4] + cc[5]) + (cc[6] + cc[7]));
    unsigned S = s8;
#pragma unroll
    for (int o = 1; o < 32; o <<= 1) { const unsigned n = __shfl_down(S, o); if (n32 + o < 32) S += n; }
    const unsigned Sn = S - s8;
    unsigned mb[2] = {0u, 0u}, ma[2] = {0u, 0u}; bool fnd[2];
#pragma unroll
    for (int sl = 0; sl < 2; ++sl) {
        const unsigned need = sl ? need1 : need0, St = (S >> (16 * sl)) & 0xffffu, Snt = (Sn >> (16 * sl)) & 0xffffu;
        fnd[sl] = (St >= need) && (Snt < need);
        unsigned ab = Snt; bool done = false;
#pragma unroll
        for (int j = 7; j >= 0; --j) { const unsigned cj = (cc[j] >> (16 * sl)) & 0xffffu; if (!done && ab + cj >= need) { mb[sl] = 8 * n32 + j; ma[sl] = ab; done = true; } if (!done) ab += cj; }
    }
    const unsigned long long f0 = __ballot(fnd[0]), f1 = __ballot(fnd[1]);
    const unsigned h0 = hi ? (unsigned)(f0 >> 32) : (unsigned)f0, h1 = hi ? (unsigned)(f1 >> 32) : (unsigned)f1;
    const int s0 = 32 * hi + (h0 ? __builtin_ctz(h0) : 0), s1 = 32 * hi + (h1 ? __builtin_ctz(h1) : 0);
    bin0 = __shfl(mb[0], s0); above0 = __shfl(ma[0], s0); bin1 = __shfl(mb[1], s1); above1 = __shfl(ma[1], s1);
}

constexpr int SEL_KBUF = 0, SEL_HIST = 131072;
__device__ __forceinline__ void select_item(Frame& F, const bf16* Z, const bf16* ikf, unsigned* mask32, int b, int c) {
    const int lane = F.lane, hi = lane >> 5, n32 = lane & 31, wv = F.wave;
    LAS unsigned* kbuf = (LAS unsigned*)(F.lds + SEL_KBUF) + wv * 4096 + lane;
    LAS unsigned* hist = (LAS unsigned*)(F.lds + SEL_HIST) + wv * 512;
    const int N = 64 * (c + 1), NKT = N / 32;
    const size_t row0 = (size_t)b * SEQ + 64 * c;
    if (c < 4) {
        for (int i = F.tid; i < 64 * 64; i += NTHREADS) { const int q = i >> 6, kt = i & 63; mask32[(row0 + q) * 64 + kt] = (kt < NKT) ? 0xffffffffu : 0u; }
        return;
    }
    unsigned one_ = 1u, hi1_ = 65536u, zero_ = 0u; asm volatile("" : "+v"(one_), "+v"(hi1_), "+v"(zero_));
    const u32x4 zero4_ = {zero_, zero_, zero_, zero_};
    const int rho = n32;
    const int a_hi = (rho >> 2) & 1, a_slot = rho >> 4, a_head = (rho & 3) + 4 * ((rho >> 3) & 1);
    const bf16* kp = ikf + ((size_t)(b * (SEQ / 32)) * 128 + hi * 32 + n32) * 8;
    LAS unsigned* hrow = hist + hi * 256;
    bf16x8 afn[2]; u32x4 wwn[2];
#define SEL_FETCH_A(rt_) do { const int qb_ = wv * 8 + (rt_) * 4; const size_t ar_ = row0 + qb_ + 2 * a_hi + a_slot; \
        _Pragma("unroll") for (int s = 0; s < 2; ++s) afn[s] = *(const bf16x8*)(Z + ar_ * NZ + C_IQ + a_head * 32 + 16 * s + 8 * hi); \
        _Pragma("unroll") for (int sl = 0; sl < 2; ++sl) wwn[sl] = *(const u32x4*)(Z + (row0 + qb_ + 2 * hi + sl) * NZ + C_IW); } while (0)
    SEL_FETCH_A(0);
#pragma unroll 1
    for (int rt = 0; rt < 2; ++rt) {
        const int qbase = wv * 8 + rt * 4;
        bf16x8 af[2] = {afn[0], afn[1]};
        float w[16];
#pragma unroll
        for (int sl = 0; sl < 2; ++sl) {
            const u32x4 ww = wwn[sl];
            w[8 * sl + 0] = bflo(ww.x); w[8 * sl + 1] = bfhi(ww.x); w[8 * sl + 2] = bflo(ww.y); w[8 * sl + 3] = bfhi(ww.y);
            w[8 * sl + 4] = bflo(ww.z); w[8 * sl + 5] = bfhi(ww.z); w[8 * sl + 6] = bflo(ww.w); w[8 * sl + 7] = bfhi(ww.w);
        }
        if (rt == 0) SEL_FETCH_A(1);
#ifndef SELREP_A
#define SELREP_A 1
#endif
#ifndef SELREP_B
#define SELREP_B 1
#endif
#ifndef SELREP_C
#define SELREP_C 1
#endif
#pragma unroll 1
        for (int repa = 0; repa < SELREP_A; ++repa) {
        constexpr int GS = 2;
        bf16x8 f0[GS][2], f1[GS][2]; f32x16 aA[GS], aB[GS];
#define SEL_LOADG(f, g) do { _Pragma("unroll") for (int j = 0; j < GS; ++j) { int kq = GS * (g) + j; kq = kq < NKT ? kq : NKT - 1; \
            f[j][0] = *(const bf16x8*)(kp + (size_t)kq * 1024); f[j][1] = *(const bf16x8*)(kp + (size_t)kq * 1024 + 512); } } while (0)
#define SEL_MMAG(a, f) do { _Pragma("unroll") for (int j = 0; j < GS; ++j) { a[j] = __builtin_amdgcn_mfma_f32_32x32x16_bf16(af[0], f[j][0], f32x16{}, 0, 0, 0); \
            a[j] = __builtin_amdgcn_mfma_f32_32x32x16_bf16(af[1], f[j][1], a[j], 0, 0, 0); } } while (0)
#define SEL_VALG(a, g) do { _Pragma("unroll") for (int j = 0; j < GS; ++j) { float s0 = 0.0f, s1 = 0.0f, t0 = 0.0f, t1 = 0.0f; \
            _Pragma("unroll") for (int rr = 0; rr < 8; rr += 2) { const float a0 = a[j][rr], a1 = a[j][8 + rr], c0 = a[j][rr + 1], c1 = a[j][9 + rr]; \
                s0 = fmaf(relu_i(a0), w[rr], s0); s1 = fmaf(relu_i(a1), w[8 + rr], s1); t0 = fmaf(relu_i(c0), w[rr + 1], t0); t1 = fmaf(relu_i(c1), w[9 + rr], t1); } \
            if (GS * (g) + j < NKT) kbuf[(GS * (g) + j) * 64] = key16x2(s0 + t0, s1 + t1); } } while (0)
        SEL_LOADG(f0, 0); SEL_LOADG(f1, 1);
        SEL_MMAG(aA, f0);
        SEL_LOADG(f0, 2);
#pragma unroll 1
        for (int g = 0; GS * g < NKT; g += 2) {
            SEL_MMAG(aB, f1); SEL_LOADG(f1, g + 3); SEL_VALG(aA, g);
            SEL_MMAG(aA, f0); SEL_LOADG(f0, g + 4); SEL_VALG(aB, g + 1);
        }
#undef SEL_LOADG
#undef SEL_MMAG
#undef SEL_VALG
        }
#pragma unroll 1
        for (int repb = 0; repb < SELREP_B; ++repb) {
#pragma unroll
        for (int j = 0; j < 2; ++j) *(LAS u32x4*)(hist + j * 256 + 4 * lane) = zero4_;
        asm volatile("s_waitcnt lgkmcnt(0)" ::: "memory");
#pragma unroll 4
        for (int kt = 0; kt < NKT; ++kt) {
            const unsigned k = kbuf[kt * 64];
            (void)__hip_atomic_fetch_add(hrow + ((k >> 8) & 255u), one_, __ATOMIC_RELAXED, __HIP_MEMORY_SCOPE_WORKGROUP);
            (void)__hip_atomic_fetch_add(hrow + (k >> 24), hi1_, __ATOMIC_RELAXED, __HIP_MEMORY_SCOPE_WORKGROUP);
        }
        asm volatile("s_waitcnt lgkmcnt(0)" ::: "memory");
        }
        unsigned b1_0, b1_1, nn0, nn1;
        { unsigned ab0, ab1; hist_find4(hist, 256u, 256u, lane, b1_0, ab0, b1_1, ab1); nn0 = 256u - ab0; nn1 = 256u - ab1; }
#pragma unroll
        for (int j = 0; j < 2; ++j) *(LAS u32x4*)(hist + j * 256 + 4 * lane) = zero4_;
        asm volatile("s_waitcnt lgkmcnt(0)" ::: "memory");
#pragma unroll 4
        for (int kt = 0; kt < NKT; ++kt) {
            const unsigned k = kbuf[kt * 64];
            if (((k >> 8) & 255u) == b1_0) (void)__hip_atomic_fetch_add(hrow + (k & 255u), one_, __ATOMIC_RELAXED, __HIP_MEMORY_SCOPE_WORKGROUP);
            if ((k >> 24) == b1_1) (void)__hip_atomic_fetch_add(hrow + ((k >> 16) & 255u), hi1_, __ATOMIC_RELAXED, __HIP_MEMORY_SCOPE_WORKGROUP);
        }
        asm volatile("s_waitcnt lgkmcnt(0)" ::: "memory");
        unsigned tau0, tau1, R0, R1;
        { unsigned bn0, bn1, ab0, ab1; hist_find4(hist, nn0, nn1, lane, bn0, ab0, bn1, ab1); tau0 = (b1_0 << 8) | bn0; tau1 = (b1_1 << 8) | bn1; R0 = nn0 - ab0; R1 = nn1 - ab1; }
#pragma unroll 1
        for (int repc = 0; repc < SELREP_C; ++repc) {
        unsigned cnt0 = 0, cnt1 = 0;
        const unsigned lowmask = (1u << n32) - 1u;
        LAS unsigned* mwb = hist;
        asm volatile("s_waitcnt lgkmcnt(0)" ::: "memory");
        *(LAS u32x4*)(mwb + 4 * lane) = zero4_;
        asm volatile("s_waitcnt lgkmcnt(0)" ::: "memory");
#pragma unroll 4
        for (int kt = 0; kt < NKT; ++kt) {
            const unsigned k = kbuf[kt * 64];
            const unsigned u0 = k & 0xffffu, u1 = k >> 16;
            unsigned long long g0 = __ballot(u0 > tau0), g1 = __ballot(u1 > tau1);
            const unsigned long long e0 = __ballot(u0 >= tau0), e1 = __ballot(u1 >= tau1);
            if (g0 != e0) {
                const unsigned long long be = e0 & ~g0;
                const unsigned mine = hi ? (unsigned)(be >> 32) : (unsigned)be;
                const bool sel = (u0 > tau0) || ((u0 == tau0) && (cnt0 + __builtin_popcount(mine & lowmask)) < R0);
                cnt0 += __builtin_popcount(mine);
                g0 = __ballot(sel);
            }
            if (g1 != e1) {
                const unsigned long long be = e1 & ~g1;
                const unsigned mine = hi ? (unsigned)(be >> 32) : (unsigned)be;
                const bool sel = (u1 > tau1) || ((u1 == tau1) && (cnt1 + __builtin_popcount(mine & lowmask)) < R1);
                cnt1 += __builtin_popcount(mine);
                g1 = __ballot(sel);
            }
            if (n32 == 0) { mwb[(2 * hi) * 64 + kt] = hi ? (unsigned)(g0 >> 32) : (unsigned)g0; mwb[(2 * hi + 1) * 64 + kt] = hi ? (unsigned)(g1 >> 32) : (unsigned)g1; }
        }
        asm volatile("s_waitcnt lgkmcnt(0)" ::: "memory");
        { const u32x4 wv4 = *(const LAS u32x4*)(mwb + 4 * lane); *(u32x4*)(mask32 + (row0 + qbase + (lane >> 4)) * 64 + 4 * (lane & 15)) = wv4; }
        }
        asm volatile("s_waitcnt lgkmcnt(0)" ::: "memory");
    }
}

#undef SEL_FETCH_A
__device__ __forceinline__ void select_phase(Frame& F, const bf16* Z, const bf16* ikf, unsigned* mask32) {
    for (int v = F.bid; v < 256; v += F.G) {
        const int b = v & 15, s = v >> 4;
#pragma unroll 1
        for (int k = 0; k < 2; ++k) select_item(F, Z, ikf, mask32, b, k ? s : 31 - s);
    }
}

#ifdef DBG_SELECT_REF
__device__ __forceinline__ void select_ref_phase(Frame& F, const bf16* Z, unsigned* mask32) {
    LAS unsigned short* keys = (LAS unsigned short*)(F.lds + F.wave * 8192);
    LAS float* qs = (LAS float*)(F.lds + F.wave * 8192 + 4096);
    const int lane = F.lane;
    for (int qi = F.bid * NWAVES + F.wave; qi < MTOK; qi += F.G * NWAVES) {
        const int t = qi % SEQ, b = qi / SEQ, c = t / 64, N = 64 * (c + 1);
        if (N <= 256) { mask32[(size_t)qi * 64 + lane] = (lane < N / 32) ? 0xffffffffu : 0u; continue; }
        for (int i = lane; i < 256; i += 64) qs[i] = bf2f(Z[(size_t)qi * NZ + C_IQ + i]);
        asm volatile("s_waitcnt lgkmcnt(0)" ::: "memory");
        for (int i = 0; i < N / 64; ++i) {
            const int key = lane + 64 * i;
            const bf16* kr = Z + ((size_t)b * SEQ + key) * NZ + C_IK;
            u32x4 kw[4];
#pragma unroll
            for (int d = 0; d < 4; ++d) kw[d] = ((const u32x4*)kr)[d];
            float sc = 0.f;
#pragma unroll 1
            for (int h = 0; h < 8; ++h) { float dot = 0.f;
#pragma unroll
                for (int d = 0; d < 4; ++d) {
                    dot = fmaf(qs[h * 32 + 8 * d + 0], bflo(kw[d].x), dot); dot = fmaf(qs[h * 32 + 8 * d + 1], bfhi(kw[d].x), dot);
                    dot = fmaf(qs[h * 32 + 8 * d + 2], bflo(kw[d].y), dot); dot = fmaf(qs[h * 32 + 8 * d + 3], bfhi(kw[d].y), dot);
                    dot = fmaf(qs[h * 32 + 8 * d + 4], bflo(kw[d].z), dot); dot = fmaf(qs[h * 32 + 8 * d + 5], bfhi(kw[d].z), dot);
                    dot = fmaf(qs[h * 32 + 8 * d + 6], bflo(kw[d].w), dot); dot = fmaf(qs[h * 32 + 8 * d + 7], bfhi(kw[d].w), dot); }
                sc = fmaf(fmaxf(dot, 0.f), bf2f(Z[(size_t)qi * NZ + C_IW + h]), sc); }
            keys[key] = (unsigned short)key16(sc);
        }
        asm volatile("s_waitcnt lgkmcnt(0)" ::: "memory");
        unsigned tau = 0;
        for (int bit = 15; bit >= 0; --bit) {
            const unsigned cand = tau | (1u << bit); unsigned cnt = 0;
            for (int i = 0; i < N / 64; ++i) cnt += __builtin_popcountll(__ballot((unsigned)keys[lane + 64 * i] >= cand));
            if (cnt >= 256u) tau = cand;
        }
        unsigned cgt = 0;
        for (int i = 0; i < N / 64; ++i) cgt += __builtin_popcountll(__ballot((unsigned)keys[lane + 64 * i] > tau));
        const unsigned R = 256u - cgt; unsigned run = 0;
        for (int i = 0; i < 32; ++i) {
            unsigned long long bs = 0ull;
            if (i < N / 64) {
                const unsigned u = keys[lane + 64 * i];
                const unsigned long long be = __ballot(u == tau);
                const unsigned rank = run + __builtin_popcountll(be & ((1ull << lane) - 1ull));
                run += __builtin_popcountll(be);
                bs = __ballot(u > tau || (u == tau && rank < R));
            }
            if (lane == 0) { mask32[(size_t)qi * 64 + 2 * i] = (unsigned)bs; mask32[(size_t)qi * 64 + 2 * i + 1] = (unsigned)(bs >> 32); }
        }
    }
}
#endif

__device__ __forceinline__ void glds16(const void* gsrc, unsigned lds_dst) {
    unsigned keep;
    asm volatile("s_mov_b32 %0, m0\n\ts_mov_b32 m0, %2\n\ts_nop 0\n\tglobal_load_lds_dwordx4 %1, off\n\ts_mov_b32 m0, %0" : "=&s"(keep) : "v"(gsrc), "s"(lds_dst) : "memory");
}
__device__ __forceinline__ void glds16s(const void* sbase, unsigned voff, unsigned lds_dst) {
    unsigned keep;
    asm volatile("s_mov_b32 %0, m0\n\ts_mov_b32 m0, %3\n\ts_nop 0\n\tglobal_load_lds_dwordx4 %1, %2\n\ts_mov_b32 m0, %0" : "=&s"(keep) : "v"(voff), "s"(sbase), "s"(lds_dst) : "memory");
}
__device__ __forceinline__ unsigned hilo(float f) { const unsigned ph = cvtpk_s(f, 0.f) & 0xffffu; const float hf = __uint_as_float(ph << 16); return ph | (cvtpk_s(f - hf, 0.f) << 16); }
__device__ __forceinline__ float mask_sel(float v, unsigned m) { const unsigned u = __float_as_uint(v); return __uint_as_float((u & m) | (0xff800000u & ~m)); }
namespace att2 {
#define SBAR() __builtin_amdgcn_sched_barrier(0)
__device__ __forceinline__ void cmask(f32x16&p0,f32x16&p1,int jb,int qrel,int hi){
  const float NEG=-INFINITY; int kb=64*jb+4*hi;
  #pragma unroll
  for(int r=0;r<16;++r){int kv=kb+(r&3)+8*(r>>2); if(kv>qrel)p0[r]=NEG; if(kv+32>qrel)p1[r]=NEG;}
}

constexpr int NSLOT=3, SLOTB=8192;
constexpr int NW=8,QBLK=32,QB=256,KVBLK=64;
constexpr int LDS_K=0, LDS_V=NSLOT*SLOTB, LDS_WS=2*NSLOT*SLOTB, LDS_OST=LDS_WS+NW*64*4, LDS_X=LDS_OST+NW*4096, LDS_BYTES=LDS_X+65536;
__device__ __forceinline__ float max3f(float a,float b,float c){float r;asm("v_max3_f32 %0, %1, %2, %3":"=v"(r):"v"(a),"v"(b),"v"(c));return r;}
__device__ __forceinline__ float max2f(float a,float b){float r;asm("v_max_f32_e32 %0, %1, %2":"=v"(r):"v"(a),"v"(b));return r;}
__device__ __forceinline__ float fadd_s(float a,float b){float r;asm("v_add_f32_e32 %0, %1, %2":"=v"(r):"v"(a),"v"(b));return r;}
__device__ __forceinline__ float fsub_s(float a,float b){float r;asm("v_sub_f32_e32 %0, %1, %2":"=v"(r):"v"(a),"v"(b));return r;}
#define WAIT_BAR(N) asm volatile("s_waitcnt vmcnt(" #N ") lgkmcnt(0)\n\ts_barrier":::"memory")

__device__ __forceinline__ void qkt(f32x16&p0,f32x16&p1,const char*Kslot,const bf16x8*qr,int r32,int hi){
  const char*kb=Kslot+hi*1024+r32*16;
  #pragma unroll
  for(int d0=0;d0<4;++d0){
    const bf16x8 b0=*reinterpret_cast<const bf16x8*>(kb+d0*2048);
    const bf16x8 b1=*reinterpret_cast<const bf16x8*>(kb+d0*2048+512);
    p0=__builtin_amdgcn_mfma_f32_32x32x16_bf16(b0,qr[d0],p0,0,0,0);p1=__builtin_amdgcn_mfma_f32_32x32x16_bf16(b1,qr[d0],p1,0,0,0);}
}
typedef __attribute__((address_space(3))) const char* lds_cptr;
typedef short v4i16_t __attribute__((ext_vector_type(4)));
__device__ __forceinline__ void kload8(bf16x8*kf,lds_cptr kp){
  kf[0]=*(const __attribute__((address_space(3))) bf16x8*)(kp);      kf[1]=*(const __attribute__((address_space(3))) bf16x8*)(kp+512);
  kf[2]=*(const __attribute__((address_space(3))) bf16x8*)(kp+2048); kf[3]=*(const __attribute__((address_space(3))) bf16x8*)(kp+2560);
  kf[4]=*(const __attribute__((address_space(3))) bf16x8*)(kp+4096); kf[5]=*(const __attribute__((address_space(3))) bf16x8*)(kp+4608);
  kf[6]=*(const __attribute__((address_space(3))) bf16x8*)(kp+6144); kf[7]=*(const __attribute__((address_space(3))) bf16x8*)(kp+6656);
}
__device__ __forceinline__ void kload2(bf16x8*kf,lds_cptr kp,int j){ kf[2*j]=*(const __attribute__((address_space(3))) bf16x8*)(kp+j*2048); kf[2*j+1]=*(const __attribute__((address_space(3))) bf16x8*)(kp+j*2048+512); }
__device__ __forceinline__ s16x4 vtr(lds_cptr p){ return __builtin_bit_cast(s16x4,__builtin_amdgcn_ds_read_tr16_b64_v4i16((__attribute__((address_space(3))) v4i16_t*)p)); }
__device__ __forceinline__ float rowmax(const f32x16&p0,const f32x16&p1){
  float a=max3f(p0[0],p0[1],p1[0]),b=max3f(p0[2],p0[3],p1[1]);a=max3f(a,p1[2],p1[3]);
  #pragma unroll
  for(int r=4;r<16;r+=4){a=max3f(a,p0[r],p0[r+1]);b=max3f(b,p0[r+2],p0[r+3]);a=max3f(a,p1[r],p1[r+1]);b=max3f(b,p1[r+2],p1[r+3]);}
  const float m=max2f(a,b);
  auto rr=__builtin_amdgcn_permlane32_swap(__float_as_uint(m),__float_as_uint(m),false,false);
  return max2f(__uint_as_float(rr[0]),__uint_as_float(rr[1]));
}
__device__ __forceinline__ void pv(f32x16*o,int vb,bf16x8 pa0,bf16x8 pa1,bf16x8 pa2,bf16x8 pa3){
  #pragma unroll
  for(int d0=0;d0<2;++d0){s16x4 lo[4],hi[4];
    #pragma unroll
    for(int ks=0;ks<4;++ks){
      asm volatile("ds_read_b64_tr_b16 %0,%1 offset:%c2":"=&v"(lo[ks]):"v"(vb),"i"(d0*4096+ks*1024):"memory");
      asm volatile("ds_read_b64_tr_b16 %0,%1 offset:%c2":"=&v"(hi[ks]):"v"(vb),"i"(d0*4096+ks*1024+512):"memory");}
    asm volatile("s_waitcnt lgkmcnt(0)":::"memory");SBAR();
    #define PK(k) (bf16x8){lo[k][0],lo[k][1],lo[k][2],lo[k][3],hi[k][0],hi[k][1],hi[k][2],hi[k][3]}
    o[d0]=__builtin_amdgcn_mfma_f32_32x32x16_bf16(pa0,PK(0),o[d0],0,0,0);
    o[d0]=__builtin_amdgcn_mfma_f32_32x32x16_bf16(pa1,PK(1),o[d0],0,0,0);
    o[d0]=__builtin_amdgcn_mfma_f32_32x32x16_bf16(pa2,PK(2),o[d0],0,0,0);
    o[d0]=__builtin_amdgcn_mfma_f32_32x32x16_bf16(pa3,PK(3),o[d0],0,0,0);
    #undef PK
  }
}

template<bool FOX,int THRL,bool LATE> __device__ __forceinline__ void attn_unit(int tid,int b,int h,int qb,const bf16*Z,const float*F2,const unsigned*mask32,bf16*mixed,char*shm,
    bool pre,bool hasn,bool nfox,int bn,int hn,int qbn,bf16x8 (&qr)[4],float&fq2){
  asm volatile("":"+v"(tid));
  const int lane=tid&63,r32=lane&31,hi=lane>>5; const int wid=__builtin_amdgcn_readfirstlane(tid>>6);
  constexpr int CQ=FOX?C_FQ:C_DQ, CK=FOX?C_FK:C_DK, CV=FOX?C_FV:C_DV, CG=FOX?C_FG:C_DG, CO=FOX?640:256, DMP=NZ;
  const long rowbase=(long)b*SEQ; const int q0=qb*QB;
  const bf16*Qw=Z+(rowbase+q0+wid*QBLK)*DMP+CQ+h*64;
  const bf16*Kh=Z+rowbase*DMP+CK+h*64,*Vh=Z+rowbase*DMP+CV+h*64;
  const float*F2r=F2+(long)(b*NH+h)*SEQ;
  const int NT=(q0+QB)/KVBLK;
  const unsigned lds0=(unsigned)(uintptr_t)shm;
  float*wsf=(float*)(shm+LDS_WS)+wid*64;
  const unsigned koff=(unsigned)(lane*DMP+wid*8)*2u;
  const unsigned voff=(unsigned)((16*(wid&3)+(lane>>2))*DMP+(wid>>2)*32+(lane&3)*8)*2u;
  const unsigned kdst=lds0+LDS_K+wid*1024, vdst=lds0+LDS_V+wid*1024;
  #define DMA_K(t,slot) glds16s(Kh+(long)(t)*KVBLK*DMP,koff,(unsigned)__builtin_amdgcn_readfirstlane(kdst+(slot)))
  #define DMA_V(t,slot) glds16s(Vh+(long)(t)*KVBLK*DMP,voff,(unsigned)__builtin_amdgcn_readfirstlane(vdst+(slot)))
  const int vb0=(int)(lds0+LDS_V)+((lane>>4)&1)*32+(lane&3)*8+(4*hi+((lane&15)>>2))*64;
  const char*Kbase=shm+LDS_K; bf16x8 kf[8];
  const lds_cptr shm3=(lds_cptr)shm; const lds_cptr kp0=shm3+LDS_K+hi*1024+r32*16; const lds_cptr vp0=shm3+LDS_V+((lane>>4)&1)*32+(lane&3)*8+(4*hi+((lane&15)>>2))*64;
  #define ISSUE_XK(F2r_,mrow_,Kh_,NT_) do{ \
    if(FOX){ const char*kar_=(const char*)F2+(WS_KA-WS_F2)+((const char*)(F2r_)-(const char*)F2)*8; for(int p=wid;p<2*(NT_);p+=8) glds16s(kar_+p*1024,(unsigned)lane*16u,(unsigned)__builtin_amdgcn_readfirstlane(lds0+LDS_X+p*1024)); } \
    else{ for(int p=wid;p<2*(NT_);p+=8) glds16s(mask32+((long)((mrow_)+(p&3)*64))*64+(p>>2)*4,(unsigned)lane*256u,(unsigned)__builtin_amdgcn_readfirstlane(lds0+LDS_X+p*1024)); } \
    glds16s((Kh_),koff,(unsigned)__builtin_amdgcn_readfirstlane(kdst)); }while(0)
  #define ISSUE_XKR(fx_,F2r_,mrow_,Kh_,NT_) do{ \
    if(fx_){ const char*kar_=(const char*)F2+(WS_KA-WS_F2)+((const char*)(F2r_)-(const char*)F2)*8; for(int p=wid;p<2*(NT_);p+=8) glds16s(kar_+p*1024,(unsigned)lane*16u,(unsigned)__builtin_amdgcn_readfirstlane(lds0+LDS_X+p*1024)); } \
    else{ for(int p=wid;p<2*(NT_);p+=8) glds16s(mask32+((long)((mrow_)+(p&3)*64))*64+(p>>2)*4,(unsigned)lane*256u,(unsigned)__builtin_amdgcn_readfirstlane(lds0+LDS_X+p*1024)); } \
    glds16s((Kh_),koff,(unsigned)__builtin_amdgcn_readfirstlane(kdst)); }while(0)
  #define LOADQR(fx_,Qw_,F2r_,qrow_) do{ _Pragma("unroll") for(int d0=0;d0<4;++d0)qr[d0]=*reinterpret_cast<const bf16x8*>(&(Qw_)[(long)r32*DMP+d0*16+hi*8]); fq2=(fx_)?(F2r_)[(qrow_)+r32]:0.f; }while(0)
  #define LOADQ(Qw_,F2r_,qrow_) do{ _Pragma("unroll") for(int d0=0;d0<4;++d0)qr[d0]=*reinterpret_cast<const bf16x8*>(&(Qw_)[(long)r32*DMP+d0*16+hi*8]); fq2=FOX?(F2r_)[(qrow_)+r32]:0.f; }while(0)
  if(!pre){ ISSUE_XK(F2r,rowbase+q0,Kh,NT); DMA_V(0,0); DMA_K(1,SLOTB);
    LOADQ(Qw,F2r,q0+wid*QBLK); DMA_K(2,2*SLOTB); }
  else { DMA_V(0,0); }
  float mhat=FOX?-fq2:0.f;f32x16 o[2];o[0]=f32x16{};o[1]=f32x16{};
  bf16x8 qa=bf16x8{};
  bf16x8 onesa=bf16x8{}; if(!FOX){ int oc2_=0x3f80; asm volatile("":"+v"(oc2_)); const unsigned o1_=hi?0u:((unsigned)oc2_<<16), o2_=hi?0u:((unsigned)oc2_|((unsigned)oc2_<<16)); const u32x4 oa_={0u,o1_,o2_,0u}; onesa=__builtin_bit_cast(bf16x8,oa_); }
  const lds_cptr lutp=(lds_cptr)shm+149504;
  #define MKQA() do{ { const float nm_=-mhat; const unsigned b0_=__float_as_uint(nm_)&0xffff0000u; const float r1_=nm_-__uint_as_float(b0_); const unsigned b1_=__float_as_uint(r1_)&0xffff0000u; \
      const float r2_=r1_-__uint_as_float(b1_); const unsigned b2_=__float_as_uint(r2_)&0xffff0000u; const unsigned on_=hi?0u:0xffffffffu; \
      const u32x4 q_={0xbf80bf80u&on_,(0xbf80u|b0_)&on_,((b1_>>16)|b2_)&on_,0u}; qa=__builtin_bit_cast(bf16x8,q_); } }while(0)
  MKQA();
  f32x4 ls={0.f,0.f,0.f,0.f}; bf16x8 onesb; { int oc_=0x3f80; asm volatile("":"+v"(oc_)); const short ov_=(lane==0||lane==32||lane==17||lane==49)?(short)oc_:(short)0; onesb=(bf16x8){ov_,ov_,ov_,ov_,ov_,ov_,ov_,ov_}; }
  const lds_cptr xp0=(lds_cptr)shm+LDS_X;
  const int qrel=wid*QBLK+r32;
  #define INIT(X0,X1,tt) do{ const float nm_=-mhat; if(FOX){ const lds_cptr kp_=xp0+((64*(tt)+r32)*32+hi*16); \
      const bf16x8 ka0_=*(const __attribute__((address_space(3))) bf16x8*)(kp_), ka1_=*(const __attribute__((address_space(3))) bf16x8*)(kp_+1024); \
      X0=__builtin_amdgcn_mfma_f32_32x32x16_bf16(ka0_,qa,f32x16{},0,0,0); X1=__builtin_amdgcn_mfma_f32_32x32x16_bf16(ka1_,qa,f32x16{},0,0,0); (void)nm_; } else { \
      const u32x2 mw_=*(const __attribute__((address_space(3))) u32x2*)(xp0+((((tt)>>1)*256+wid*32+r32)*16+((tt)&1)*8)); const unsigned wl_=mw_.x>>(4*hi), wh_=mw_.y>>(4*hi); \
      _Pragma("unroll") for(int i_=0;i_<4;++i_){ const f32x4 va_=*(const __attribute__((address_space(3))) f32x4*)(lutp+((wl_>>(8*i_))&15u)*16u), vb_=*(const __attribute__((address_space(3))) f32x4*)(lutp+((wh_>>(8*i_))&15u)*16u); \
        _Pragma("unroll") for(int j_=0;j_<4;++j_){ X0[4*i_+j_]=va_[j_]; X1[4*i_+j_]=vb_[j_]; } } \
      X0=__builtin_amdgcn_mfma_f32_32x32x16_bf16(onesa,qa,X0,0,0,0); X1=__builtin_amdgcn_mfma_f32_32x32x16_bf16(onesa,qa,X1,0,0,0); (void)nm_; } }while(0)
  #define CMASK(P0,P1,t) do{ if(FOX){int jb_=(t)-(NT-4); if(jb_>=0)cmask(P0,P1,jb_,qrel,hi);} }while(0)
  bool resc=false;
  #define START(P0,P1) do{ const float rm=rowmax(P0,P1); resc=false; \
    { const float dl=__builtin_fmaxf(rm,0.f); mhat=fadd_s(mhat,dl); \
      _Pragma("unroll") for(int r=0;r<16;++r){P0[r]=fsub_s(P0[r],dl);P1[r]=fsub_s(P1[r],dl);} \
      } \
    if(!LATE){ _Pragma("unroll") for(int r=0;r<16;++r)P0[r]=__builtin_amdgcn_exp2f(P0[r]); } }while(0)
  #define RESC() do{ if(resc){ asm volatile("s_waitcnt lgkmcnt(0)":::"memory"); \
      _Pragma("unroll") for(int d_=0;d_<2;++d_) _Pragma("unroll") for(int r=0;r<16;++r)o[d_][r]*=wsf[crow(r,hi)]; \
      _Pragma("unroll") for(int j_=0;j_<4;++j_)ls[j_]*=wsf[16*(lane&1)+4*(lane>>4)+j_]; } }while(0)
  f32x16 pA0,pA1,pB0,pB1;
  int sl_prev=0,sl_cur=0,sl_next=SLOTB;
  #define ROT() do{sl_prev=sl_cur;sl_cur=sl_next;sl_next=(sl_next==(NSLOT-1)*SLOTB)?0:sl_next+SLOTB;}while(0)
  WAIT_BAR(3);
  INIT(pA0,pA1,0);
  qkt(pA0,pA1,Kbase,qr,r32,hi);asm volatile("s_nop 15\n\ts_nop 7":"+v"(pA0),"+v"(pA1));CMASK(pA0,pA1,0);
  START(pA0,pA1); MKQA();
  INIT(pB0,pB1,1);
  if(!LATE){ _Pragma("unroll") for(int r=0;r<16;++r)pA1[r]=__builtin_amdgcn_exp2f(pA1[r]); }
  WAIT_BAR(0);
  DMA_K(3,0);DMA_V(1,SLOTB);
  ROT();
  kload8(kf,kp0+sl_cur);
  WAIT_BAR(2);
  s16x4 vlo[8],vhi[8]; u32x4 pw0,pw1,pw2,pw3;
  #define PKW(P,B) cvtpk_s(P[B],P[B+1])
  #define PAF(k) __builtin_bit_cast(bf16x8,pw##k)
  #define VFR(i) (bf16x8){vlo[i][0],vlo[i][1],vlo[i][2],vlo[i][3],vhi[i][0],vhi[i][1],vhi[i][2],vhi[i][3]}
  #define PIN(x) asm volatile("":"+v"(x))
  #define MX3(a,b,c) __builtin_fmaxf(__builtin_fmaxf((a),(b)),(c))
  #define EX4(P,B) do{ P[B]=EX(P[B]); P[B+1]=EX(P[B+1]); P[B+2]=EX(P[B+2]); P[B+3]=EX(P[B+3]); }while(0)
  #define GAPA(MF,XP,XB,W0,W1,PW) do{ MF; if(LATE&&PL_&&(XB)>=0){ EX4(XP,((XB)<0?0:(XB))); } W0; W1; PIN(PW); SBAR(); }while(0)
  #define LSUM(k) ls=__builtin_amdgcn_mfma_f32_16x16x32_bf16(PAF(k),onesb,ls,0,0,0)
  #define EX(v) __builtin_amdgcn_exp2f(v)
  #define GAPB(MF,X,B) do{ MF; if(!LATE&&LIVE_){ X[B]=EX(X[B]); X[B+1]=EX(X[B+1]); X[B+2]=EX(X[B+2]); X[B+3]=EX(X[B+3]); } PIN(X); SBAR(); }while(0)
  #define VRD(i) do{ vlo[i]=vtr(vp_+(((i)>>2)*4096+((i)&3)*1024)); vhi[i]=vtr(vp_+(((i)>>2)*4096+((i)&3)*1024+512)); }while(0)
  #define KRD(G,j) do{ if(G){ kload2(kf,kp0+sl_next,j); SBAR(); } }while(0)
  #define STEP(C0,C1,P0,P1,t,GK,GV,GL,LIVE,PLIVE) do{ const bool LIVE_=(LIVE), PL_=(PLIVE); SBAR(); \
    const lds_cptr vp_=vp0+sl_prev; \
    if(LATE&&PL_){ EX4(P0,0); } \
    GAPA(C0=__builtin_amdgcn_mfma_f32_32x32x16_bf16(kf[0],qr[0],C0,0,0,0), P0,4,     pw0[0]=PKW(P0,0), pw0[1]=PKW(P0,2), pw0); \
    GAPA(C1=__builtin_amdgcn_mfma_f32_32x32x16_bf16(kf[1],qr[0],C1,0,0,0), P0,8,     pw0[2]=PKW(P0,4), pw0[3]=PKW(P0,6), pw0); \
    GAPA(C0=__builtin_amdgcn_mfma_f32_32x32x16_bf16(kf[2],qr[1],C0,0,0,0),   P0,12, pw1[0]=PKW(P0,8), pw1[1]=PKW(P0,10), pw1); \
    GAPA(C1=__builtin_amdgcn_mfma_f32_32x32x16_bf16(kf[3],qr[1],C1,0,0,0),   P1,0,   pw1[2]=PKW(P0,12),pw1[3]=PKW(P0,14), pw1); \
    GAPA(C0=__builtin_amdgcn_mfma_f32_32x32x16_bf16(kf[4],qr[2],C0,0,0,0),   P1,4,     pw2[0]=PKW(P1,0), pw2[1]=PKW(P1,2), pw2); \
    GAPA(C1=__builtin_amdgcn_mfma_f32_32x32x16_bf16(kf[5],qr[2],C1,0,0,0),   P1,8,     pw2[2]=PKW(P1,4), pw2[3]=PKW(P1,6), pw2); \
    GAPA(C0=__builtin_amdgcn_mfma_f32_32x32x16_bf16(kf[6],qr[3],C0,0,0,0),   P1,12, pw3[0]=PKW(P1,8), pw3[1]=PKW(P1,10), pw3); \
    GAPA(C1=__builtin_amdgcn_mfma_f32_32x32x16_bf16(kf[7],qr[3],C1,0,0,0),   P0,-1,       pw3[2]=PKW(P1,12),pw3[3]=PKW(P1,14), pw3); \
    if(GK){DMA_K((t)+3,sl_cur);} if(GV){DMA_V((t)+1,sl_next);} \
    if(LIVE_){ CMASK(C0,C1,t); \
    { float a=MX3(C0[0],C0[1],C1[0]),b=MX3(C0[2],C0[3],C1[1]); a=MX3(a,C1[2],C1[3]); \
      _Pragma("unroll") for(int r=4;r<16;r+=4){a=MX3(a,C0[r],C0[r+1]);b=MX3(b,C0[r+2],C0[r+3]);a=MX3(a,C1[r],C1[r+1]);b=MX3(b,C1[r+2],C1[r+3]);} \
      float rm=__builtin_fmaxf(a,b); { auto rr=__builtin_amdgcn_permlane32_swap(__float_as_uint(rm),__float_as_uint(rm),false,false); rm=__builtin_fmaxf(__uint_as_float(rr[0]),__uint_as_float(rr[1])); } \
      resc=false; \
      if(__builtin_expect(__any(rm>(float)THRL),0)){ const float dl=__builtin_fmaxf(rm,0.f); mhat+=dl; \
        _Pragma("unroll") for(int r=0;r<16;++r){C0[r]-=dl;C1[r]-=dl;} \
        const float f=__builtin_amdgcn_exp2f(-dl); if(hi==0)wsf[r32]=f; resc=true; MKQA(); } } } \
    else { resc=false; _Pragma("unroll") for(int r=0;r<16;++r){C0[r]=0.f;C1[r]=0.f;} }     \
    if(GL){ INIT(P0,P1,(t)+1); } \
    VRD(0); VRD(4); SBAR(); \
    VRD(1); SBAR(); GAPB(o[0]=__builtin_amdgcn_mfma_f32_32x32x16_bf16(PAF(0),VFR(0),o[0],0,0,0), C0,0); \
    VRD(5); SBAR(); GAPB(o[1]=__builtin_amdgcn_mfma_f32_32x32x16_bf16(PAF(0),VFR(4),o[1],0,0,0); LSUM(0), C0,4); \
    VRD(2); SBAR(); KRD(GL,0); GAPB(o[0]=__builtin_amdgcn_mfma_f32_32x32x16_bf16(PAF(1),VFR(1),o[0],0,0,0), C0,8); \
    VRD(6); SBAR(); KRD(GL,1); GAPB(o[1]=__builtin_amdgcn_mfma_f32_32x32x16_bf16(PAF(1),VFR(5),o[1],0,0,0); LSUM(1), C0,12); \
    VRD(3); SBAR(); KRD(GL,2); GAPB(o[0]=__builtin_amdgcn_mfma_f32_32x32x16_bf16(PAF(2),VFR(2),o[0],0,0,0), C1,0); \
    VRD(7); SBAR(); KRD(GL,3); GAPB(o[1]=__builtin_amdgcn_mfma_f32_32x32x16_bf16(PAF(2),VFR(6),o[1],0,0,0); LSUM(2), C1,4); \
    GAPB(o[0]=__builtin_amdgcn_mfma_f32_32x32x16_bf16(PAF(3),VFR(3),o[0],0,0,0), C1,8); \
    GAPB(o[1]=__builtin_amdgcn_mfma_f32_32x32x16_bf16(PAF(3),VFR(7),o[1],0,0,0); LSUM(3), C1,12); \
    }while(0)
  int t=1;
  #undef CMASK
  #define CMASK(P0,P1,t) do{}while(0)
  for(;t+5<NT;t+=2){
    STEP(pB0,pB1,pA0,pA1,t,true,true,true,true,true);     WAIT_BAR(2); RESC(); ROT();
    STEP(pA0,pA1,pB0,pB1,t+1,true,true,true,true,true);   WAIT_BAR(2); RESC(); ROT();
  }
  #undef CMASK
  #define CMASK(P0,P1,t) do{ if(FOX){int jb_=(t)-(NT-4); if(jb_>=0)cmask(P0,P1,jb_,qrel,hi);} }while(0)
  #define ENDW(tt) do{ if((tt)+3<NT){WAIT_BAR(2);} else if((tt)+2<NT){WAIT_BAR(1);} else {WAIT_BAR(0);} }while(0)
  const int TW=NT-4+(wid>>1);
  for(;t+1<NT;t+=2){
    STEP(pB0,pB1,pA0,pA1,t,(t+3<NT),(t+1<NT),((t+1<NT)&&(t+1<=TW)),(t<=TW),(t-1<=TW));       ENDW(t);   RESC(); ROT();
    STEP(pA0,pA1,pB0,pB1,t+1,(t+4<NT),(t+2<NT),((t+2<NT)&&(t+2<=TW)),(t+1<=TW),(t<=TW));     ENDW(t+1); RESC(); ROT();
  }
  const long rbn=(long)bn*SEQ; const int q0n=qbn*QB, NTn=(q0n+QB)/KVBLK; const bf16*Khn=Z+rbn*DMP+(nfox?C_FK:C_DK)+hn*64; const float*F2n=F2+(long)(bn*NH+hn)*SEQ;
  if(hasn){ ISSUE_XKR(nfox,F2n,rbn+q0n,Khn,NTn);
    glds16s(Khn+(long)KVBLK*DMP,koff,(unsigned)__builtin_amdgcn_readfirstlane(kdst+SLOTB)); glds16s(Khn+(long)2*KVBLK*DMP,koff,(unsigned)__builtin_amdgcn_readfirstlane(kdst+2*SLOTB)); }
  STEP(pB0,pB1,pA0,pA1,NT-1,false,false,false,(TW==NT-1),(NT-2<=TW)); RESC();
  if(hasn){ const bf16*Qwn=Z+(rbn+q0n+wid*QBLK)*DMP+(nfox?C_FQ:C_DQ)+hn*64; LOADQR(nfox,Qwn,F2n,q0n+wid*QBLK); }
  const bf16*Gw=Z+(rowbase+q0+wid*QBLK)*DMP+CG+h*64; u32x4 gpre[4];
  _Pragma("unroll") for(int i=0;i<4;++i){const int row=i*8+(lane>>3),ch=lane&7; gpre[i]=*(const u32x4*)(Gw+(long)row*DMP+ch*8);}
  {
    if(LATE&&TW==NT-1){ _Pragma("unroll") for(int r=0;r<16;++r){pB0[r]=EX(pB0[r]);pB1[r]=EX(pB1[r]);} }
    pw0=(u32x4){PKW(pB0,0),PKW(pB0,2),PKW(pB0,4),PKW(pB0,6)};pw1=(u32x4){PKW(pB0,8),PKW(pB0,10),PKW(pB0,12),PKW(pB0,14)};pw2=(u32x4){PKW(pB1,0),PKW(pB1,2),PKW(pB1,4),PKW(pB1,6)};pw3=(u32x4){PKW(pB1,8),PKW(pB1,10),PKW(pB1,12),PKW(pB1,14)};
    SBAR(); pv(o,vb0+sl_cur,PAF(0),PAF(1),PAF(2),PAF(3)); LSUM(0); LSUM(1); LSUM(2); LSUM(3); }
  #undef PKW
  #undef PAF
  #undef VFR
  #undef PIN
  #undef MX3
  #undef GAPA
  #undef EX4
  #undef LSUM
  #undef GAPB
  #undef EX
  #undef VRD
  #undef KRD
  #undef STEP
  #undef ENDW
  if((lane&15)<2){ _Pragma("unroll") for(int j_=0;j_<4;++j_)wsf[32+16*(lane&15)+4*(lane>>4)+j_]=ls[j_]; } asm volatile("s_waitcnt lgkmcnt(0)":::"memory");
  float rli[16];
  #pragma unroll
  for(int r=0;r<16;++r)rli[r]=__builtin_amdgcn_rcpf(wsf[32+crow(r,hi)]);
  bf16*Ow=mixed+(rowbase+q0+wid*QBLK)*DM+CO+h*64;
  { bf16*stg=(bf16*)(shm+LDS_OST)+wid*2048;
    #pragma unroll
    for(int r=0;r<16;++r){const int orow=crow(r,hi);
      #pragma unroll
      for(int d0=0;d0<2;++d0)stg[orow*64+d0*32+r32]=(bf16)f2bf(o[d0][r]*rli[r]);}
    asm volatile("s_waitcnt lgkmcnt(0)":::"memory");
    #pragma unroll
    for(int i=0;i<4;++i){const int row=i*8+(lane>>3),ch=lane&7; const u32x4 v=*(const u32x4*)(stg+row*64+ch*8); const u32x4 g=gpre[i]; u32x4 ov;
      ov.x=pk2(bflo(v.x)*silu_f(bflo(g.x)),bfhi(v.x)*silu_f(bfhi(g.x))); ov.y=pk2(bflo(v.y)*silu_f(bflo(g.y)),bfhi(v.y)*silu_f(bfhi(g.y)));
      ov.z=pk2(bflo(v.z)*silu_f(bflo(g.z)),bfhi(v.z)*silu_f(bfhi(g.z))); ov.w=pk2(bflo(v.w)*silu_f(bflo(g.w)),bfhi(v.w)*silu_f(bfhi(g.w)));
      *(u32x4*)(Ow+(long)row*DM+ch*8)=ov;} }
  asm volatile("s_waitcnt lgkmcnt(0)\n\ts_barrier":::"memory");
  #undef DMA_K
  #undef DMA_V
  #undef ISSUE_XK
  #undef LOADQ
  #undef LOADQR
  #undef ISSUE_XKR
  #undef CMASK
  #undef INIT
  #undef MKQA
  #undef START
  #undef RESC
  #undef ROT
}

#undef SBAR
#undef WAIT_BAR
}

template <bool FOX>
__device__ __forceinline__ void attn_run(Frame& F, int xcd, int gq, int m, int pass, const bf16* Z, const float* F2, const unsigned* mask32, bf16* mixed, bf16x8 (&qr)[4], float& fq2) {
    const int nu = pass ? 2 : 4;
#pragma unroll 1
    for (int u = 0; u < nu; ++u) {
        const int j = pass ? 1 : (u >> 1) * 2, k = u & 1, sid = xcd * 24 + 8 * j + ((gq + j) & 7), bh = sid >> 1, b = bh / NH, h = bh % NH, qb = k ? m : 7 - m;
        const int un = u + 1; const bool cross = (un == nu);
        const int jn = (pass || cross) ? 1 : (un >> 1) * 2, kn = un & 1, sidn = xcd * 24 + 8 * jn + ((gq + jn) & 7), bhn = sidn >> 1;
        att2::attn_unit<FOX, 8, true>(F.tid, b, h, qb, Z, F2, mask32, mixed, F.ldsg, (u > 0) || (pass == 1), (un < nu) || (pass == 0), cross ? !FOX : FOX, bhn / NH, bhn % NH, kn ? m : 7 - m, qr, fq2);
    }
}
__device__ __forceinline__ void attn_phase(Frame& F, const bf16* Z, const float* F2, const unsigned* mask32, bf16* mixed) {
    for (int vb = F.bid; vb < 256; vb += F.G) {
        const int v = (F.G == 256) ? (vb & 7) * 32 + (vb >> 3) : vb;
        const int xcd = v >> 5, c = v & 31, gq = c >> 2, m = c & 3;
        bf16x8 qr[4]; float fq2 = 0.f;
#pragma unroll 1
        for (int pass = 0; pass < 2; ++pass) {
            const bool fox = (((gq + pass) & 1) == 0);
            if (fox) attn_run<true>(F, xcd, gq, m, pass, Z, F2, mask32, mixed, qr, fq2);
            else attn_run<false>(F, xcd, gq, m, pass, Z, F2, mask32, mixed, qr, fq2);
        }
    }
}

__device__ __forceinline__ void final_phase(Frame& F, const bf16* xb, float* xo, const float* part, const float* fg) {
    const int gw = F.bid * NWAVES + F.wave, NGW = F.G * NWAVES;
    f32x4 gv[4];
#pragma unroll
    for (int j = 0; j < 4; ++j) gv[j] = ((const f32x4*)fg)[64 * j + F.lane];
    for (int m0 = gw; m0 < MTOK; m0 += 4 * NGW) {
        float pv[4]; u32x2 w[4][4];
#pragma unroll
        for (int r = 0; r < 4; ++r) { const int m = m0 + r * NGW; pv[r] = 0.f; if (m < MTOK) { pv[r] = (F.lane < 16) ? part[(size_t)m * 16 + F.lane] : 0.f;
            const u32x2* xr = (const u32x2*)(xb + (size_t)m * DM) + F.lane;
#pragma unroll
            for (int j = 0; j < 4; ++j) w[r][j] = xr[64 * j]; } }
#pragma unroll
        for (int r = 0; r < 4; ++r) { const int m = m0 + r * NGW; if (m < MTOK) {
            const float s = wave_sum(pv[r]);
            const float rs = __builtin_amdgcn_rsqf(s * (1.0f / 1024.0f) + 1e-6f);
            f32x4* orow = (f32x4*)(xo + (size_t)m * DM) + F.lane;
#pragma unroll
            for (int j = 0; j < 4; ++j) { f32x4 v = {bflo(w[r][j].x), bfhi(w[r][j].x), bflo(w[r][j].y), bfhi(w[r][j].y)}; v = v * rs * gv[j]; orow[64 * j] = v; } } }
    }
}

#define XB_TMO      128
#define XB_XCNT(j)  (256  + 64 * (j))
#define XB_XSUB(j)  (1280 + 64 * (j))
#define XB_XGEN(j)  (2304 + 64 * (j))
#define XB_TOP      3328
#define XB_TOPGEN   3392
#define XCD_BAR_WORDS 3456
#define XB_SPIN_CAP (1u << 18)

__device__ __forceinline__ unsigned xb_ld(unsigned* p)              { return __hip_atomic_load(p, __ATOMIC_RELAXED, __HIP_MEMORY_SCOPE_AGENT); }
__device__ __forceinline__ unsigned xb_add(unsigned* p, unsigned v) { return __hip_atomic_fetch_add(p, v, __ATOMIC_RELAXED, __HIP_MEMORY_SCOPE_AGENT); }
__device__ __forceinline__ unsigned xb_xcc_id() { return (unsigned)__builtin_amdgcn_s_getreg((3 << 11) | 20) & 0xFu; }
#define XB_SPIN(cond, bar) do { unsigned _sp = 0; while (cond) { __builtin_amdgcn_s_sleep(1); \
    if ((++_sp & 255u) == 0u) { if (xb_ld(&(bar)[XB_TMO])) break; if (_sp > XB_SPIN_CAP) { atomicAdd(&(bar)[XB_TMO], 1u); break; } } } } while (0)

struct XcdBarrier {
    unsigned* bar; unsigned x;
    int tid;
    volatile LAS unsigned* st;
};

__device__ __forceinline__ XcdBarrier xcd_barrier_post(unsigned* bar, volatile LAS unsigned* st) {
    XcdBarrier b; b.bar = bar; b.x = xb_xcc_id(); b.st = st; b.tid = (int)threadIdx.x;
    if (threadIdx.x == 0) (void)xb_add(&bar[XB_XCNT(b.x)], 1u);
    return b;
}
__device__ __forceinline__ void xcd_barrier_complete(unsigned* bar, unsigned x, unsigned& nloc, unsigned& nx) {
    const unsigned G = gridDim.x * gridDim.y * gridDim.z;
    unsigned sum, cnt, mine, sp = 0u;
    for (;;) {
        sum = 0u; cnt = 0u; mine = 0u;
#pragma unroll
        for (unsigned j = 0; j < 16; ++j) { const unsigned c = xb_ld(&bar[XB_XCNT(j)]); sum += c; cnt += (c > 0u) ? 1u : 0u; mine = (j == x) ? c : mine; }
        if (sum == G) break;
        __builtin_amdgcn_s_sleep(1);
        if ((++sp & 255u) == 0u) { if (xb_ld(&bar[XB_TMO])) break; if (sp > XB_SPIN_CAP) { atomicAdd(&bar[XB_TMO], 1u); break; } }
    }
    nloc = mine > 0u ? mine : 1u; nx = cnt > 0u ? cnt : 1u;
}

__device__ __forceinline__ void xcd_barrier(const XcdBarrier& b) {
    asm volatile("s_waitcnt vmcnt(0)" ::: "memory");
    __syncthreads();
    if (b.tid == 0) {
        unsigned* bar = b.bar;
        __builtin_amdgcn_s_waitcnt(0);
        unsigned nloc = b.st[0], nx = b.st[1];
        if (nloc == 0u) { xcd_barrier_complete(bar, b.x, nloc, nx); b.st[0] = nloc; b.st[1] = nx; }
        const unsigned old = xb_add(&bar[XB_XSUB(b.x)], 1u);
        const unsigned gen = old / nloc;
        if (old + 1u == (gen + 1u) * nloc) {
            __builtin_amdgcn_fence(__ATOMIC_RELEASE, "agent");
            asm volatile("s_waitcnt vmcnt(0)" ::: "memory");
            const unsigned og = xb_add(&bar[XB_TOP], 1u);
            const unsigned tg = og / nx;
            if (og + 1u == (tg + 1u) * nx) xb_add(&bar[XB_TOPGEN], 1u);
            else XB_SPIN(xb_ld(&bar[XB_TOPGEN]) == tg, bar);
            __builtin_amdgcn_fence(__ATOMIC_ACQUIRE, "agent");
            xb_add(&bar[XB_XGEN(b.x)], 1u);
            asm volatile("s_waitcnt vmcnt(0)" ::: "memory");
        } else {
            XB_SPIN(xb_ld(&bar[XB_XGEN(b.x)]) == gen, bar);
            __builtin_amdgcn_fence(__ATOMIC_ACQUIRE, "agent");
            asm volatile("s_waitcnt vmcnt(0)" ::: "memory");
        }
    }
    __syncthreads();
}

struct Args { const float* x; const float* w_in; const float* norm_g; const float* pool_w; const float* pool_scale; const float* fox_bf; const float* w_out; const float* final_g;
              float* out; unsigned char* ws; int ph_lo, ph_hi; };
constexpr int N_PHASES = 18;

__global__ void __launch_bounds__(NTHREADS, 2) mk_fwd(Args a) {
    extern __shared__ __attribute__((aligned(16))) unsigned char lds_raw[];
    Frame F;
    F.lds = (LAS unsigned char*)lds_raw; F.ldsg = (char*)lds_raw;
    F.tid = threadIdx.x; F.lane = F.tid & 63; F.wave = __builtin_amdgcn_readfirstlane(F.tid >> 6);
    const int wave0_ = F.wave;
    F.G = gridDim.x; F.bid = blockIdx.x;
#if MK_FUSED
    volatile LAS unsigned* MISC = (volatile LAS unsigned*)(F.lds + LDS_BYTES - 64);
    if (threadIdx.x < 16) MISC[threadIdx.x] = 0u;
    if (threadIdx.x < 64) ((LAS unsigned*)(F.lds + LDS_LUT))[threadIdx.x] = ((threadIdx.x >> 2) >> (threadIdx.x & 3)) & 1u ? 0u : 0xff800000u;
    __syncthreads();
    (void)xcd_barrier_post((unsigned*)(a.ws + WS_CTL) + CW_BAR, MISC);
#define GRID_BAR() do { XcdBarrier bar_; bar_.bar = (unsigned*)(ws + WS_CTL) + CW_BAR; bar_.x = xb_xcc_id(); bar_.st = MISC; { int w2_ = wave0_; asm volatile("" : "+s"(w2_)); int t2_; asm volatile("v_mbcnt_lo_u32_b32 %0, -1, 0\n\tv_mbcnt_hi_u32_b32 %0, -1, %0" : "=v"(t2_)); bar_.tid = t2_ + 64 * w2_; } xcd_barrier(bar_); } while (0)
#else
#define GRID_BAR() do { } while (0)
#endif
#ifndef PHMASK
#define PHMASK 0x3f
#endif
#define FRAME_TID() do { int w_ = wave0_; asm volatile("" : "+s"(w_)); int t_; asm volatile("v_mbcnt_lo_u32_b32 %0, -1, 0\n\tv_mbcnt_hi_u32_b32 %0, -1, %0" : "=v"(t_)); t_ += 64 * w_;     F.tid = t_; F.lane = t_ & 63; F.wave = __builtin_amdgcn_readfirstlane(t_ >> 6); } while (0)
    int rep_ = 0; (void)rep_;
    for (int ph = a.ph_lo; ph < a.ph_hi; ++ph) {
        { int b_ = blockIdx.x; asm volatile("" : "+s"(b_)); F.bid = b_; int g_ = gridDim.x; asm volatile("" : "+s"(g_)); F.G = g_; }
        unsigned long long wsi_ = (unsigned long long)a.ws; asm volatile("" : "+s"(wsi_)); unsigned char* ws = (unsigned char*)(__attribute__((address_space(1))) unsigned char*)wsi_;
        bf16* Zb = (bf16*)(ws + WS_Z); bf16* XB = (bf16*)(ws + WS_XB); bf16* MIX = (bf16*)(ws + WS_MIX);
        float* PART = (float*)(ws + WS_PART); float* F2 = (float*)(ws + WS_F2);
        if (ph == 0) {
            FRAME_TID();
            if (PHMASK & 1)
            p0_prep(F, a.x, a.w_in, a.norm_g, a.pool_w, a.w_out, ws);
        } else if (ph == N_PHASES - 1) {
            FRAME_TID();
            if (PHMASK & 32) final_phase(F, XB, a.out, PART, a.final_g);
        } else {
            const int l = (ph - 1) >> 2, sub = (ph - 1) & 3;
            unsigned* MASK = (unsigned*)(ws + WS_MASK + (size_t)l * 8 * MiB);
            if (sub == 0 && (PHMASK & 2)) {
                FRAME_TID();
                pg8::Gemm g{XB, (const pg8::bf16_t*)(ws + WS_WIN) + (size_t)l * NZ * 1024, MTOK, NZ, DM};
                pg8::StaticOrder S; S.init(MTOK, NZ, F.G, F.bid);
                LAS float* rtab = (LAS float*)(F.lds + 131072);
                asm volatile("s_waitcnt lgkmcnt(0)" ::: "memory");
                pg8::EpiZ E{Zb, NZ, PART, (bf16*)(ws + WS_IKF), rtab};
                pg8::gemm_phase<pg8::EpiZ, pg8::StaticOrder, PG8_ALIGN, PG8_SP2>(F.lds, g, S, E, F.tid);
            } else if (sub == 1 && (PHMASK & 4)) {
                FRAME_TID();
                scan_phase(F, Zb, a.fox_bf + l * NH, F2);
#if defined(REP_PART) && REP_PART == 1
                scan_phase(F, Zb, a.fox_bf + l * NH, F2); scan_phase(F, Zb, a.fox_bf + l * NH, F2);
#endif
                pool_phase(F, Zb, (const bf16*)(ws + WS_PW) + (size_t)l * 4 * 4096, a.pool_scale + l * 256, MIX);
#if defined(REP_PART) && REP_PART == 2
                pool_phase(F, Zb, (const bf16*)(ws + WS_PW) + (size_t)l * 4 * 4096, a.pool_scale + l * 256, MIX);
#endif
#if defined(REP_PART) && REP_PART == 3
                select_phase(F, Zb, (const bf16*)(ws + WS_IKF), MASK);
#endif
#ifdef DBG_SELECT_REF
                select_ref_phase(F, Zb, MASK);
#else
                select_phase(F, Zb, (const bf16*)(ws + WS_IKF), MASK);
#endif
            } else if (sub == 2 && (PHMASK & 8)) {
                FRAME_TID();
                attn_phase(F, Zb, F2, MASK, MIX);
            } else if (sub == 3 && (PHMASK & 16)) {
                FRAME_TID();
                pg8::Gemm g{MIX, (const pg8::bf16_t*)(ws + WS_WOUT) + (size_t)l * 1024 * 1024, MTOK, DM, DM};
                pg8::StaticOrder S; S.init(MTOK, DM, F.G, F.bid);
                pg8::EpiOut E{nullptr, nullptr, XB, PART};
                pg8::gemm_phase<pg8::EpiOut, pg8::StaticOrder, PG8_ALIGN, PG8_SP2>(F.lds, g, S, E, F.tid);
            }
        }
#ifdef REP_SUB
        if (ph >= 1 && ph < N_PHASES - 1 && ((ph - 1) & 3) == REP_SUB && rep_ == 0) { rep_ = 1; GRID_BAR(); --ph; continue; }
        rep_ = 0;
#endif
#ifdef REP_PH
        if (ph == REP_PH && rep_ < 4) { ++rep_; GRID_BAR(); --ph; continue; }
        rep_ = 0;
#endif
        if (ph + 1 < a.ph_hi) GRID_BAR();
    }
}

extern "C" void kernel_launch(void* const* d_in, const int* in_sizes, int n_in, void* d_out, int out_size, void* d_ws, size_t ws_size, hipStream_t stream) {
    static int grid = 0;
    if (grid == 0) {
        if (n_in != 8 || in_sizes[0] != MTOK * DM || out_size != MTOK * DM || ws_size < WS_END) {
            fprintf(stderr, "kernel_launch: unexpected shapes (n_in %d, in0 %d, out %d, ws %zu)\n", n_in, n_in > 0 ? in_sizes[0] : -1, out_size, ws_size); grid = -1; return; }
        int dev = 0, cus = 0, per_cu = 0;
        hipGetDevice(&dev); hipDeviceGetAttribute(&cus, hipDeviceAttributeMultiprocessorCount, dev);
        hipFuncSetAttribute((const void*)mk_fwd, hipFuncAttributeMaxDynamicSharedMemorySize, LDS_BYTES);
        hipOccupancyMaxActiveBlocksPerMultiprocessor(&per_cu, (const void*)mk_fwd, NTHREADS, LDS_BYTES);
        if (per_cu < 1) { fprintf(stderr, "kernel_launch: occupancy query says %d blocks per CU\n", per_cu); per_cu = 1; }
        (void)hipGetLastError();
        grid = cus;
    }
    if (grid < 0) return;
    (void)hipMemsetAsync((char*)d_ws + WS_CTL + (size_t)CW_BAR * 4, 0, (size_t)XCD_BAR_WORDS * 4, stream);
    Args a{};
    a.x = (const float*)d_in[0]; a.w_in = (const float*)d_in[1]; a.norm_g = (const float*)d_in[2]; a.pool_w = (const float*)d_in[3]; a.pool_scale = (const float*)d_in[4];
    a.fox_bf = (const float*)d_in[5]; a.w_out = (const float*)d_in[6]; a.final_g = (const float*)d_in[7];
    a.out = (float*)d_out; a.ws = (unsigned char*)d_ws;
#if MK_FUSED
    a.ph_lo = 0; a.ph_hi = N_PHASES;
    void* args[] = {&a};
    hipError_t e = hipLaunchCooperativeKernel((const void*)mk_fwd, dim3(grid), dim3(NTHREADS), args, LDS_BYTES, stream);
    if (e != hipSuccess) fprintf(stderr, "cooperative launch failed: %s (grid %d)\n", hipGetErrorString(e), grid);
#else
    for (int ph = 0; ph < N_PHASES; ++ph) {
        a.ph_lo = ph; a.ph_hi = ph + 1;
        hipLaunchKernelGGL(mk_fwd, dim3(grid), dim3(NTHREADS), LDS_BYTES, stream, a);
    }
#endif
}
```

```cpp
#include <hip/hip_runtime.h>
#include <hip/hip_cooperative_groups.h>
#include <hip/hip_bf16.h>
#include <hip/hip_fp16.h>
#include <cstdio>
#include <cstdint>
#include <cmath>
namespace pg8 {
#define PG8_LAS __attribute__((address_space(3)))
typedef unsigned short bf16_t;
typedef short bf16x8 __attribute__((ext_vector_type(8)));
typedef float f32x4 __attribute__((ext_vector_type(4)));
typedef unsigned u32x4 __attribute__((ext_vector_type(4)));
constexpr int BM = 256, BK = 64, HALF = 128, HTB = HALF * BK * 2  , STAGE_BYTES = 8 * HTB, NXCD = 8, WGM = 8;

__host__ __device__ __forceinline__ int lds_byte(int r, int c) { const int st = (r >> 4) * 2 + (c >> 5), rr = r & 15, cc = c & 31, ob = rr * 64 + cc * 2; return st * 1024 + (ob ^ (((ob >> 9) & 1) << 5)); }
__host__ __device__ __forceinline__ void stage_rc(int b, int& R, int& C) { const int st = b / 1024, sb = b % 1024, swz = sb ^ (((sb >> 9) & 1) << 5); R = (st >> 1) * 16 + swz / 64; C = (st & 1) * 32 + (swz % 64) / 2; }
__host__ __device__ __forceinline__ int perm32(int rho) { const int n = rho >> 4, i = rho & 15; return 8 * (i >> 2) + 4 * n + (i & 3); }

struct Unit { int pm, pn; };
struct Gemm { const bf16_t* A; const bf16_t* Bt; int M, N, K; };

struct StaticOrder {
    int nM, nN, nwg, G, c, wgm;
    __host__ __device__ void init(int M, int N, int G_, int c_, int wgm_ = WGM) { nM = M / BM; nN = N / BM; nwg = nM * nN; G = G_; c = c_; wgm = wgm_; }
    __host__ __device__ bool next(int i, Unit& u) const {
        const long L = (long)i * G + c; if (L >= nwg) return false;
        if (wgm == -2) {
            const int x = (int)(L % NXCD), off = (int)(L / NXCD), j = off & 31, r = off >> 5;
            u.pm = 32 * (x >> 1) + 16 * r + (j & 15); u.pn = 2 * (x & 1) + (j >> 4); return true;
        }
        if (wgm < 0) {
            const int x = (int)(L % NXCD), off = (int)(L / NXCD), j = off & 31, r = off >> 5;
            u.pm = 32 * (x >> 1) + 4 * r + (j & 3); u.pn = 8 * (x & 1) + (j >> 2); return true;
        }
        int wgid = (int)L; { const int q = nwg / NXCD, r = nwg % NXCD, xcd = wgid % NXCD, off = wgid / NXCD; wgid = (xcd < r ? xcd * (q + 1) : r * (q + 1) + (xcd - r) * q) + off; }
        const int nig = wgm * nN, gid = wgid / nig, fm = gid * wgm, gsz = (nM - fm) < wgm ? (nM - fm) : wgm;
        u.pm = fm + ((wgid % nig) % gsz); u.pn = (wgid % nig) / gsz; return true;
    }
    __device__ __forceinline__ void a_ready(const Unit&) const {}
    __device__ __forceinline__ void done(const Unit&) const {}
};


__device__ __forceinline__ unsigned cvt_pk_bf16(float lo, float hi) { unsigned r; asm volatile("v_cvt_pk_bf16_f32 %0, %1, %2" : "=v"(r) : "v"(lo), "v"(hi)); return r; }
typedef unsigned u32x2v __attribute__((ext_vector_type(2)));

__device__ __forceinline__ unsigned dpp_pair(unsigned v) { return (unsigned)__builtin_amdgcn_mov_dpp((int)v, 0xB1, 0xf, 0xf, true); }
template <bool NT = false>
__device__ __forceinline__ void store_row_pair(bf16_t* p_even, size_t ld, const u32x4& w0, const u32x4& w1, bool odd) {
    u32x4 p0, p1, i1, i2;
    p0.x = dpp_pair(w0.x); p0.y = dpp_pair(w0.y); p0.z = dpp_pair(w0.z); p0.w = dpp_pair(w0.w);
    p1.x = dpp_pair(w1.x); p1.y = dpp_pair(w1.y); p1.z = dpp_pair(w1.z); p1.w = dpp_pair(w1.w);
    i1.x = odd ? p1.x : w0.x; i1.y = odd ? p1.y : w0.y; i1.z = odd ? p1.z : w0.z; i1.w = odd ? p1.w : w0.w;
    i2.x = odd ? w1.x : p0.x; i2.y = odd ? w1.y : p0.y; i2.z = odd ? w1.z : p0.z; i2.w = odd ? w1.w : p0.w;
    if constexpr (NT) {
        asm volatile("global_store_dwordx4 %0, %1, off sc1\n\ts_nop 1" :: "v"(p_even), "v"(i1) : "memory");
        asm volatile("global_store_dwordx4 %0, %1, off sc1\n\ts_nop 1" :: "v"(p_even + ld), "v"(i2) : "memory"); }
    else { *(u32x4*)(p_even) = i1; *(u32x4*)(p_even + ld) = i2; }
}

struct EpiZ {
    static constexpr bool PERM = true, AFTER_DRAIN = false, HAS_PF = true;
    bf16_t* Z; int ldz; const float* part; bf16_t* ikf; PG8_LAS float* tab;
    __device__ __forceinline__ void prefetch(const Unit& u, int wid) const {
        unsigned voff; asm volatile("v_mbcnt_lo_u32_b32 %0, -1, 0\n\tv_mbcnt_hi_u32_b32 %0, -1, %0\n\tv_lshlrev_b32 %0, 4, %0" : "=v"(voff));
        const float* src = part + (size_t)u.pm * BM * 16 + wid * 512;
        const unsigned dst = (unsigned)(size_t)tab + (unsigned)wid * 2048u;
#pragma unroll
        for (int i = 0; i < 2; ++i) {
            unsigned keep;
            asm volatile("s_mov_b32 %0, m0\n\ts_mov_b32 m0, %3\n\ts_nop 0\n\tglobal_load_lds_dwordx4 %1, %2\n\ts_mov_b32 m0, %0" : "=&s"(keep) : "v"(voff), "s"(src + i * 256), "s"(dst + i * 1024u) : "memory");
        }
    }
    __device__ __forceinline__ void operator()(const f32x4 (&acc)[2][2][4][2], const Unit& u, int wr, int wc, int fr, int fq) const {
        if (u.pn == 15 && wc != 0) return;
        const int row0 = u.pm * BM + wr * 64 + fr;
        const int col0 = u.pn * BM + wc * 64 + 8 * fq;
        const int odd = fr & 1;
        const PG8_LAS float* t = tab + (wr * 64 + fr) * 16 + 4 * fq;
#pragma unroll
        for (int ai = 0; ai < 2; ++ai)
#pragma unroll
            for (int m = 0; m < 4; ++m) {
                const int row = row0 + ai * HALF + m * 16;
                const f32x4 pq = *(const PG8_LAS f32x4*)(t + (ai * HALF + m * 16) * 16);
                float s = (pq[0] + pq[1]) + (pq[2] + pq[3]);
                s += __shfl_xor(s, 16); s += __shfl_xor(s, 32);
                const float rs = __builtin_amdgcn_rsqf(s * (1.0f / 1024.0f) + 1e-6f);
                u32x4 w[2];
#pragma unroll
                for (int bj = 0; bj < 2; ++bj) {
                    const f32x4 v0 = acc[ai][bj][m][0] * rs, v1 = acc[ai][bj][m][1] * rs;
                    w[bj].x = cvt_pk_bf16(v0[0], v0[1]); w[bj].y = cvt_pk_bf16(v0[2], v0[3]); w[bj].z = cvt_pk_bf16(v1[0], v1[1]); w[bj].w = cvt_pk_bf16(v1[2], v1[3]);
                }
                store_row_pair(Z + (size_t)(row - odd) * ldz + col0 + 32 * odd, (size_t)ldz, w[0], w[1], odd);
                if (wc == 0 && u.pn == 15) *(u32x4*)(ikf + ((size_t)(row >> 5) * 128 + fq * 32 + (row & 31)) * 8) = w[0];
            }
    }
};

struct EpiOut {
    static constexpr bool PERM = true, AFTER_DRAIN = false, HAS_PF = false;
    const float* xin; float* xout; bf16_t* xb; float* part;
    __device__ __forceinline__ void operator()(const f32x4 (&acc)[2][2][4][2], const Unit& u, int wr, int wc, int fr, int fq) const {
        const int col0 = u.pn * BM + wc * 64 + 8 * fq;
        const int rbase = u.pm * BM + wr * 64 + fr;
        if (xin) {
#pragma unroll
            for (int g = 0; g < 8; ++g) {
                const int ai = g >> 2, m = g & 3, row = rbase + ai * HALF + m * 16; const size_t off = (size_t)row * 1024 + col0;
                float ss = 0.f;
#pragma unroll
                for (int bj = 0; bj < 2; ++bj) {
                    const size_t c = off + bj * 32;
                    const f32x4 o0 = *(const f32x4*)(xin + c) + acc[ai][bj][m][0], o1 = *(const f32x4*)(xin + c + 4) + acc[ai][bj][m][1];
                    ss += ((o0[0] * o0[0] + o0[1] * o0[1]) + (o0[2] * o0[2] + o0[3] * o0[3])) + ((o1[0] * o1[0] + o1[1] * o1[1]) + (o1[2] * o1[2] + o1[3] * o1[3]));
                    u32x4 w; w.x = cvt_pk_bf16(o0[0], o0[1]); w.y = cvt_pk_bf16(o0[2], o0[3]); w.z = cvt_pk_bf16(o1[0], o1[1]); w.w = cvt_pk_bf16(o1[2], o1[3]);
                    *(u32x4*)(xb + c) = w;
                }
                ss += __shfl_xor(ss, 16); ss += __shfl_xor(ss, 32);
                if (fq == 0) part[(size_t)row * 16 + u.pn * 4 + wc] = ss;
                if (g & 1) asm volatile("" ::: "memory");
            }
            return;
        }
        u32x4 nx[2];
#pragma unroll
        for (int bj = 0; bj < 2; ++bj) nx[bj] = *(const u32x4*)(xb + (size_t)rbase * 1024 + col0 + bj * 32);
#pragma unroll
        for (int g = 0; g < 8; ++g) {
            const int ai = g >> 2, m = g & 3, row = rbase + ai * HALF + m * 16; const size_t off = (size_t)row * 1024 + col0;
            u32x4 cur[2] = {nx[0], nx[1]};
            if (g < 7) { const int g1 = g + 1, row1 = rbase + (g1 >> 2) * HALF + (g1 & 3) * 16;
#pragma unroll
                for (int bj = 0; bj < 2; ++bj) nx[bj] = *(const u32x4*)(xb + (size_t)row1 * 1024 + col0 + bj * 32); }
            float ss = 0.f; u32x4 w[2];
#pragma unroll
            for (int bj = 0; bj < 2; ++bj) {
                const size_t c = off + bj * 32; const u32x4 rb = cur[bj];
                const f32x4 x0 = (f32x4){__uint_as_float(rb.x << 16), __uint_as_float(rb.x & 0xffff0000u), __uint_as_float(rb.y << 16), __uint_as_float(rb.y & 0xffff0000u)};
                const f32x4 x1 = (f32x4){__uint_as_float(rb.z << 16), __uint_as_float(rb.z & 0xffff0000u), __uint_as_float(rb.w << 16), __uint_as_float(rb.w & 0xffff0000u)};
                const f32x4 o0 = x0 + acc[ai][bj][m][0], o1 = x1 + acc[ai][bj][m][1];
                if (xout) { *(f32x4*)(xout + c) = o0; *(f32x4*)(xout + c + 4) = o1; }
                ss += ((o0[0] * o0[0] + o0[1] * o0[1]) + (o0[2] * o0[2] + o0[3] * o0[3])) + ((o1[0] * o1[0] + o1[1] * o1[1]) + (o1[2] * o1[2] + o1[3] * o1[3]));
                w[bj].x = cvt_pk_bf16(o0[0], o0[1]); w[bj].y = cvt_pk_bf16(o0[2], o0[3]); w[bj].z = cvt_pk_bf16(o1[0], o1[1]); w[bj].w = cvt_pk_bf16(o1[2], o1[3]);
            }
            { const int odd = fr & 1; store_row_pair(xb + (size_t)(row - odd) * 1024 + col0 + 32 * odd, (size_t)1024, w[0], w[1], odd); }
            ss += __shfl_xor(ss, 16); ss += __shfl_xor(ss, 32);
            if (fq == 0) part[(size_t)row * 16 + u.pn * 4 + wc] = ss;
        }
    }
};

template <class Epi, class Sched, bool ALIGN_EPI = false, bool SP2 = false>
__device__ __forceinline__ void gemm_phase(PG8_LAS unsigned char* lds, const Gemm g, const Sched& S, const Epi& E, int tid_in) {
    int tid0_ = tid_in; asm volatile("" : "+v"(tid0_));
    const int tid = tid0_, wid = __builtin_amdgcn_readfirstlane(tid >> 6), lane = tid & 63, wr = wid >> 2, wc = wid & 3, fr = lane & 15, fq = lane >> 4;
    const int K = g.K, nt = K / BK;
    unsigned voffA[2], voffB[2];
#pragma unroll
    for (int i = 0; i < 2; ++i) { int R, C; stage_rc(tid * 16 + i * 8192, R, C); const int Rb = Epi::PERM ? ((R & ~31) + perm32(R & 31)) : R;
        voffA[i] = (unsigned)(R * K + C) * 2u; voffB[i] = (unsigned)((64 * (Rb >> 5) + (Rb & 31)) * K + C) * 2u; }
    const size_t kstep = (size_t)(BK * 2);
    const size_t hstep = (size_t)HALF * K * 2;
    const size_t hstepB = (size_t)32 * K * 2;
    const size_t tstep = 2 * hstep;
    const unsigned ldsw = (unsigned)wid * 1024u;
    const int aoff = lds_byte(wr * 64 + fr, fq * 8), boff = lds_byte(wc * 32 + fr, fq * 8);
#define PG8_SA(b, h) (((b) * 2 + (h)) * HTB)
#define PG8_SB(b, h) ((4 + (b) * 2 + (h)) * HTB)
#define PG8_STAGE(bufoff, gbase, voff) do { _Pragma("unroll") for (int _i = 0; _i < 2; ++_i) \
        __builtin_amdgcn_global_load_lds((const unsigned*)((const char*)(gbase) + (voff)[_i]), (PG8_LAS unsigned*)(lds + (bufoff) + ldsw + _i * 8192), 16, 0, 0); } while (0)
#define PG8_LDA(dst, b, h) do { _Pragma("unroll") for (int m = 0; m < 4; ++m) _Pragma("unroll") for (int k = 0; k < 2; ++k) dst[m][k] = *(const PG8_LAS bf16x8*)(lds + PG8_SA(b, h) + aoff + m * 2048 + k * 1024); } while (0)
#define PG8_LDB(dst, b, h) do { _Pragma("unroll") for (int n = 0; n < 2; ++n) _Pragma("unroll") for (int k = 0; k < 2; ++k) dst[n][k] = *(const PG8_LAS bf16x8*)(lds + PG8_SB(b, h) + boff + n * 2048 + k * 1024); } while (0)
#define PG8_MMA(ai, bj, At, Bt) do { __builtin_amdgcn_s_setprio(1); _Pragma("unroll") for (int m = 0; m < 4; ++m) _Pragma("unroll") for (int n = 0; n < 2; ++n) _Pragma("unroll") for (int k = 0; k < 2; ++k) \
        acc[ai][bj][m][n] = __builtin_amdgcn_mfma_f32_16x16x32_bf16(Bt[n][k], At[m][k], acc[ai][bj][m][n], 0, 0, 0); __builtin_amdgcn_s_setprio(0); } while (0)
#define PG8_WAIT_V(n) asm volatile("s_waitcnt vmcnt(" #n ")" ::: "memory")
#define PG8_WAIT_L(n) asm volatile("s_waitcnt lgkmcnt(" #n ")" ::: "memory")
#define PG8_BAR __builtin_amdgcn_s_barrier()
#define PG8_SCHED __builtin_amdgcn_sched_barrier(0)
    Unit cur, nxt; int ui = 0;
    if (!S.next(0, cur)) return;
    f32x4 acc[2][2][4][2];
#pragma unroll
    for (int a = 0; a < 2; ++a)
#pragma unroll
        for (int b = 0; b < 2; ++b)
#pragma unroll
            for (int m = 0; m < 4; ++m)
#pragma unroll
                for (int n = 0; n < 2; ++n) acc[a][b][m][n] = (f32x4){0.f, 0.f, 0.f, 0.f};
    bf16x8 At[4][2], B0[2][2], B1[2][2];
    const char* cA = (const char*)g.A + (size_t)cur.pm * tstep; const char* cB = (const char*)g.Bt + (size_t)cur.pn * tstep;
    S.a_ready(cur);
    if constexpr (SP2) {
        PG8_STAGE(PG8_SB(0, 0), cB, voffB); PG8_STAGE(PG8_SB(0, 1), cB + hstepB, voffB); PG8_STAGE(PG8_SA(0, 0), cA, voffA); PG8_STAGE(PG8_SA(0, 1), cA + hstep, voffA);
        if (wr == 1) PG8_BAR;
        PG8_WAIT_V(2); PG8_BAR;
        PG8_STAGE(PG8_SB(1, 0), cB + kstep, voffB); PG8_STAGE(PG8_SA(1, 0), cA + kstep, voffA); PG8_STAGE(PG8_SB(1, 1), cB + hstepB + kstep, voffB);
        PG8_WAIT_V(6); PG8_BAR;
    } else {
        PG8_STAGE(PG8_SB(0, 0), cB, voffB); PG8_STAGE(PG8_SA(0, 0), cA, voffA); PG8_STAGE(PG8_SB(0, 1), cB + hstepB, voffB); PG8_STAGE(PG8_SA(0, 1), cA + hstep, voffA);
        if (wr == 1) PG8_BAR;
        PG8_WAIT_V(4); PG8_BAR;
        PG8_STAGE(PG8_SB(1, 0), cB + kstep, voffB); PG8_STAGE(PG8_SA(1, 0), cA + kstep, voffA); PG8_STAGE(PG8_SB(1, 1), cB + hstepB + kstep, voffB);
        PG8_WAIT_V(6); PG8_BAR;
    }
    for (;;) {
        const bool has_next = S.next(ui + 1, nxt);
        const char* nA = has_next ? (const char*)g.A + (size_t)nxt.pm * tstep : cA; const char* nB = has_next ? (const char*)g.Bt + (size_t)nxt.pn * tstep : cB;
        for (int t = 0; t < nt; t += 2) {
            const bool last = (t == nt - 2);
            const char* a1 = cA + (size_t)(t + 1) * kstep;
            const char* a2 = last ? nA : cA + (size_t)(t + 2) * kstep; const char* b2 = last ? nB : cB + (size_t)(t + 2) * kstep;
            const char* a3 = a2 + kstep; const char* b3 = b2 + kstep;
            if (last && has_next) S.a_ready(nxt);
            if constexpr (SP2) {
            PG8_LDB(B0, 0, 0); PG8_LDB(B1, 0, 1); PG8_SCHED; PG8_LDA(At, 0, 0); PG8_STAGE(PG8_SA(1, 1), a1 + hstep, voffA);
            PG8_WAIT_V(8); PG8_WAIT_L(0); PG8_BAR; PG8_MMA(0, 0, At, B0); PG8_MMA(0, 1, At, B1); PG8_BAR; PG8_SCHED;
            PG8_LDA(At, 0, 1); PG8_STAGE(PG8_SB(0, 0), b2, voffB); PG8_STAGE(PG8_SB(0, 1), b2 + hstepB, voffB); PG8_STAGE(PG8_SA(0, 0), a2, voffA);
            PG8_WAIT_V(8); PG8_WAIT_L(0); PG8_BAR; PG8_MMA(1, 0, At, B0); PG8_MMA(1, 1, At, B1); PG8_BAR; PG8_SCHED;
            PG8_LDB(B0, 1, 0); PG8_LDB(B1, 1, 1); PG8_SCHED; PG8_LDA(At, 1, 0); PG8_STAGE(PG8_SA(0, 1), a2 + hstep, voffA);
            PG8_WAIT_V(8); PG8_WAIT_L(0); PG8_BAR; PG8_MMA(0, 0, At, B0); PG8_MMA(0, 1, At, B1); PG8_BAR; PG8_SCHED;
            PG8_LDA(At, 1, 1); PG8_STAGE(PG8_SB(1, 0), b3, voffB); PG8_STAGE(PG8_SB(1, 1), b3 + hstepB, voffB); PG8_STAGE(PG8_SA(1, 0), a3, voffA);
            PG8_WAIT_V(8); PG8_WAIT_L(0); PG8_BAR; PG8_MMA(1, 0, At, B0); PG8_MMA(1, 1, At, B1); PG8_BAR; PG8_SCHED;
            if constexpr (Epi::HAS_PF) { if (t == 4) E.prefetch(cur, wid); }
            } else {
            PG8_LDB(B0, 0, 0); PG8_SCHED; PG8_LDA(At, 0, 0); PG8_STAGE(PG8_SA(1, 1), a1 + hstep, voffA);
            PG8_WAIT_L(8); PG8_BAR; PG8_WAIT_L(0); PG8_MMA(0, 0, At, B0); PG8_BAR; PG8_SCHED;
            PG8_LDB(B1, 0, 1); PG8_STAGE(PG8_SB(0, 0), b2, voffB);
            PG8_BAR; PG8_WAIT_L(0); PG8_MMA(0, 1, At, B1); PG8_BAR;
            PG8_LDA(At, 0, 1); PG8_STAGE(PG8_SA(0, 0), a2, voffA);
            PG8_BAR; PG8_WAIT_L(0); PG8_MMA(1, 0, At, B0); PG8_BAR; PG8_SCHED;
            PG8_STAGE(PG8_SB(0, 1), b2 + hstepB, voffB);
            PG8_WAIT_V(6); PG8_BAR; PG8_MMA(1, 1, At, B1); PG8_BAR;
            PG8_LDB(B0, 1, 0); PG8_SCHED; PG8_LDA(At, 1, 0); PG8_STAGE(PG8_SA(0, 1), a2 + hstep, voffA);
            PG8_WAIT_L(8); PG8_BAR; PG8_WAIT_L(0); PG8_MMA(0, 0, At, B0); PG8_BAR; PG8_SCHED;
            PG8_LDB(B1, 1, 1); PG8_STAGE(PG8_SB(1, 0), b3, voffB);
            PG8_BAR; PG8_WAIT_L(0); PG8_MMA(0, 1, At, B1); PG8_BAR;
            PG8_LDA(At, 1, 1); PG8_STAGE(PG8_SA(1, 0), a3, voffA);
            PG8_BAR; PG8_WAIT_L(0); PG8_MMA(1, 0, At, B0); PG8_BAR; PG8_SCHED;
            PG8_STAGE(PG8_SB(1, 1), b3 + hstepB, voffB);
            PG8_WAIT_V(6); PG8_BAR; PG8_MMA(1, 1, At, B1); PG8_BAR;
            }
        }
        if constexpr (ALIGN_EPI) { if (wr == 0) PG8_BAR; }
        if constexpr (!Epi::AFTER_DRAIN) { E(acc, cur, wr, wc, fr, fq); S.done(cur); }
        if (!has_next) break;
#pragma unroll
        for (int a = 0; a < 2; ++a)
#pragma unroll
            for (int b = 0; b < 2; ++b)
#pragma unroll
                for (int m = 0; m < 4; ++m)
#pragma unroll
                    for (int n = 0; n < 2; ++n) acc[a][b][m][n] = (f32x4){0.f, 0.f, 0.f, 0.f};
        cur = nxt; cA = nA; cB = nB; ++ui;
        if constexpr (ALIGN_EPI) { if (wr == 1) PG8_BAR; }
    }
    PG8_WAIT_V(0);
    if constexpr (!ALIGN_EPI) { if (wr == 0) PG8_BAR; }
    PG8_BAR;
    if constexpr (Epi::AFTER_DRAIN) { E.fused(acc, cur, wr, wc, fr, fq, lds, wid, lane); S.done(cur); }
#undef PG8_SA
#undef PG8_SB
#undef PG8_STAGE
#undef PG8_LDA
#undef PG8_LDB
#undef PG8_MMA
#undef PG8_WAIT_V
#undef PG8_WAIT_L
#undef PG8_BAR
#undef PG8_SCHED
}
}

#ifndef PG8_SP2
#define PG8_SP2 true
#ifndef WGM_IN
#define WGM_IN (F.G == 256 ? -1 : 4)
#endif
#ifndef WGM_OUT
#define WGM_OUT (F.G == 256 ? -2 : 16)
#endif
#endif
#ifndef PG8_ALIGN
#define PG8_ALIGN true
#endif
#ifndef MK_FUSED
#define MK_FUSED 1
#endif

namespace cg = cooperative_groups;
#define GAS __attribute__((address_space(1)))
#define LAS __attribute__((address_space(3)))
typedef unsigned short bf16;
typedef float f32x4 __attribute__((ext_vector_type(4)));
typedef float f32x16 __attribute__((ext_vector_type(16)));
typedef short bf16x8 __attribute__((ext_vector_type(8)));
typedef short s16x4 __attribute__((ext_vector_type(4)));
typedef unsigned u32x4 __attribute__((ext_vector_type(4)));
typedef unsigned u32x2 __attribute__((ext_vector_type(2)));
typedef float f32x2_p __attribute__((ext_vector_type(2)));

constexpr int NB = 16, SEQ = 2048, DM = 1024, MTOK = NB * SEQ, NZ = 4096, DEPTH = 4, NIN = 3886;
constexpr int NH = 6, HD = 64;
constexpr int C_PV = 0, C_PG = 256, C_DQ = 512, C_DK = 896, C_DV = 1280, C_DG = 1664, C_IQ = 2048, C_FQ = 2304, C_FK = 2688, C_FV = 3072, C_FG = 3456, C_IK = 3840, C_IW = 3872, C_FF = 3880;
constexpr float LOG2E = 1.4426950408889634f;
constexpr float C2 = 0.125f * LOG2E;
constexpr int NWAVES = 8, NTHREADS = 512;

constexpr size_t MiB = 1u << 20;
constexpr size_t WS_CTL = 0, CTL_ZERO_BYTES = 1 * MiB;
constexpr size_t WS_WIN = 2 * MiB;
constexpr size_t WS_WOUT = 34 * MiB;
constexpr size_t WS_PW = 42 * MiB;
constexpr size_t WS_F2 = 43 * MiB;
constexpr size_t WS_PART = 44 * MiB;
constexpr size_t WS_MASK = 46 * MiB;
constexpr size_t WS_XB = 78 * MiB;
constexpr size_t WS_MIX = 142 * MiB;
constexpr size_t WS_Z = 206 * MiB;
constexpr size_t WS_IKF = 462 * MiB;
constexpr size_t WS_KA = 464 * MiB;
constexpr size_t WS_END = 472 * MiB;
constexpr int CW_BAR = 4096;

constexpr int LDS_LUT = 149504;
constexpr int LDS_BYTES = 149504 + 256 + 256;

__device__ __forceinline__ unsigned f2bf(float f) { unsigned u = __builtin_bit_cast(unsigned, f); return (u + 0x7fffu + ((u >> 16) & 1u)) >> 16; }
typedef float f32x2_t __attribute__((ext_vector_type(2))); typedef __bf16 bf16x2_t __attribute__((ext_vector_type(2)));
__device__ __forceinline__ unsigned cvtpk_s(float lo, float hi) { f32x2_t v = {lo, hi}; bf16x2_t b = __builtin_convertvector(v, bf16x2_t); return __builtin_bit_cast(unsigned, b); }
__device__ __forceinline__ unsigned pk2(float lo, float hi) { return cvtpk_s(lo, hi); }
__device__ __forceinline__ float bf2f(unsigned short b) { return __builtin_bit_cast(float, (unsigned)b << 16); }
__device__ __forceinline__ float bflo(unsigned w) { return __builtin_bit_cast(float, w << 16); }
__device__ __forceinline__ float bfhi(unsigned w) { return __builtin_bit_cast(float, w & 0xffff0000u); }
__device__ __forceinline__ float wave_sum(float v) {
#pragma unroll
    for (int o = 1; o < 64; o <<= 1) v += __shfl_xor(v, o);
    return v;
}
__device__ __forceinline__ float silu_f(float g) { return g * __builtin_amdgcn_rcpf(1.0f + __expf(-g)); }
__device__ __forceinline__ int crow(int r, int hi) { return (r & 3) + 8 * (r >> 2) + 4 * hi; }

struct Frame {
    LAS unsigned char* lds; char* ldsg;
    int tid, lane, wave, G, bid;
};

__device__ __forceinline__ int orig_col(int n) {
    if (n < 2304) return n;
    if (n < 3840) return n + 40;
    if (n < 3872) return 2304 + (n - 3840);
    if (n < 3880) return 2336 + (n - 3872);
    if (n < 3886) return n;
    return -1;
}
template <bool IN>
__device__ __forceinline__ void p0_transpose_item(const float* W, int ldw, const float* g, bf16* WT, LAS float* scr, int item, int nblk, int lane) {
    const int kb = item / nblk, nb = item % nblk, k0 = 64 * kb, n0 = 32 * nb;
    if (IN && n0 >= 3872) {
        const int n = n0 + (lane & 31); const int oc = orig_col(n);
#pragma unroll 8
        for (int i = 0; i < 32; ++i) {
            const int kk = 2 * i + (lane >> 5);
            float v = 0.f;
            if (oc >= 0) v = W[(size_t)(k0 + kk) * ldw + oc] * g[k0 + kk];
            scr[kk * 33 + (lane & 31)] = v;
        }
    } else if (IN) {
        const int oc0 = orig_col(n0), c2 = 2 * (lane & 15), rr = lane >> 4;
        const float cs = ((n0 >= C_DQ && n0 < C_DK) || (n0 >= C_FQ && n0 < C_FK)) ? C2 : 1.f;
#pragma unroll 8
        for (int i = 0; i < 16; ++i) {
            const int kk = 4 * i + rr;
            const f32x2_p v = *(const f32x2_p*)(W + (size_t)(k0 + kk) * ldw + oc0 + c2);
            const float gs = g[k0 + kk] * cs;
            scr[kk * 33 + c2] = v[0] * gs; scr[kk * 33 + c2 + 1] = v[1] * gs;
        }
    } else {
        const int c4 = 4 * (lane & 7), rr = lane >> 3;
#pragma unroll
        for (int i = 0; i < 8; ++i) {
            const int kk = 8 * i + rr;
            const f32x4 v = *(const f32x4*)(W + (size_t)(k0 + kk) * ldw + n0 + c4);
            scr[kk * 33 + c4] = v[0]; scr[kk * 33 + c4 + 1] = v[1]; scr[kk * 33 + c4 + 2] = v[2]; scr[kk * 33 + c4 + 3] = v[3];
        }
    }
    asm volatile("s_waitcnt lgkmcnt(0)" ::: "memory");
    const int c = lane & 7;
#pragma unroll
    for (int j = 0; j < 4; ++j) {
        const int nn = (lane >> 3) + 8 * j; const LAS float* s = scr + (8 * c) * 33 + nn;
        u32x4 o; o.x = pk2(s[0 * 33], s[1 * 33]); o.y = pk2(s[2 * 33], s[3 * 33]); o.z = pk2(s[4 * 33], s[5 * 33]); o.w = pk2(s[6 * 33], s[7 * 33]);
        *(u32x4*)(WT + (size_t)(n0 + nn) * 1024 + k0 + 8 * c) = o;
    }
    asm volatile("s_waitcnt lgkmcnt(0)" ::: "memory");
}

__device__ __forceinline__ void p0_prep(Frame& F, const float* x, const float* w_in, const float* norm_g, const float* pool_w, const float* w_out, unsigned char* ws) {
    LAS float* scr = (LAS float*)(F.lds + F.wave * 16384);
    const int gw = F.bid * NWAVES + F.wave, NGW = F.G * NWAVES;
    constexpr int I_IN = 16 * 128, I_OUT = 16 * 32, I_L = I_IN + I_OUT;
    {
        bf16* pwt = (bf16*)(ws + WS_PW);
        for (int i = F.bid * NTHREADS + F.tid; i < DEPTH * 4 * 64 * 64; i += F.G * NTHREADS) {
            const int c = i & 63, d = (i >> 6) & 63, lg = i >> 12;
            pwt[i] = (bf16)f2bf(pool_w[(size_t)lg * 4096 + c * 64 + d]);
        }
    }
    bf16* xb = (bf16*)(ws + WS_XB); float* part = (float*)(ws + WS_PART);
    int it = gw;
    for (int m0 = gw; m0 < MTOK || it < DEPTH * I_L; m0 += 4 * NGW, it += NGW) {
        f32x4 v[4][4]; float s[4];
#pragma unroll
        for (int r = 0; r < 4; ++r) { const int m = m0 + r * NGW; if (m < MTOK) { const f32x4* xr = (const f32x4*)(x + (size_t)m * DM) + F.lane;
#pragma unroll
            for (int j = 0; j < 4; ++j) v[r][j] = __builtin_nontemporal_load(xr + 64 * j); } }
        if (it < DEPTH * I_L) {
            const int l = it / I_L, r = it % I_L;
            if (r < I_IN) p0_transpose_item<true>(w_in + (size_t)l * 1024 * NIN, NIN, norm_g + l * 1024, (bf16*)(ws + WS_WIN) + (size_t)l * NZ * 1024, scr, r, 128, F.lane);
            else p0_transpose_item<false>(w_out + (size_t)l * 1024 * 1024, 1024, nullptr, (bf16*)(ws + WS_WOUT) + (size_t)l * 1024 * 1024, scr, r - I_IN, 32, F.lane);
        }
#pragma unroll
        for (int r = 0; r < 4; ++r) { const int m = m0 + r * NGW; if (m < MTOK) { float t = 0.f;
#pragma unroll
            for (int j = 0; j < 4; ++j) t += (v[r][j][0] * v[r][j][0] + v[r][j][1] * v[r][j][1]) + (v[r][j][2] * v[r][j][2] + v[r][j][3] * v[r][j][3]);
            s[r] = wave_sum(t);
            unsigned long long* o8 = (unsigned long long*)(xb + (size_t)m * DM) + F.lane;
#pragma unroll
            for (int j = 0; j < 4; ++j) o8[64 * j] = (unsigned long long)pk2(v[r][j][0], v[r][j][1]) | ((unsigned long long)pk2(v[r][j][2], v[r][j][3]) << 32);
            if (F.lane < 16) part[(size_t)m * 16 + F.lane] = (F.lane == 0) ? s[r] : 0.f; } }
    }
}

__device__ __forceinline__ void scan_phase(Frame& F, const bf16* Z, const float* fox_bf  , float* F2) {
    LAS float* wtot = (LAS float*)F.lds;
    for (int vb = F.bid; vb < 256; vb += F.G) {
        if (vb < 32 || vb >= 64) continue;
        const int b = (vb - 32) & 15, h0 = 3 * ((vb - 32) >> 4);
        float cum[4][3];
        float run[3] = {0.f, 0.f, 0.f};
        const float bf0 = fox_bf[h0], bf1 = fox_bf[h0 + 1], bf2 = fox_bf[h0 + 2];
#pragma unroll
        for (int j = 0; j < 4; ++j) {
            const int t = 4 * F.tid + j;
            const u32x4 w = *(const u32x4*)(Z + (size_t)(b * SEQ + t) * NZ + C_FF);
            const float ff[6] = {bflo(w.x), bfhi(w.x), bflo(w.y), bfhi(w.y), bflo(w.z), bfhi(w.z)};
            const float x3[3] = {(h0 ? ff[3] : ff[0]) + bf0, (h0 ? ff[4] : ff[1]) + bf1, (h0 ? ff[5] : ff[2]) + bf2};
#pragma unroll
            for (int h = 0; h < 3; ++h) {
                const float xx = x3[h];
                const float ls = fminf(xx, 0.f) - __logf(1.0f + __expf(-fabsf(xx)));
                run[h] += ls * LOG2E; cum[j][h] = run[h];
            }
        }
        float pre[3];
#pragma unroll
        for (int h = 0; h < 3; ++h) {
            float v = run[h];
#pragma unroll
            for (int o = 1; o < 64; o <<= 1) { const float n = __shfl_up(v, o); if (F.lane >= o) v += n; }
            pre[h] = v - run[h];
            if (F.lane == 63) wtot[F.wave * 4 + h] = v;
        }
        __syncthreads();
#pragma unroll
        for (int h = 0; h < 3; ++h) {
            float off = 0.f;
            for (int w = 0; w < F.wave; ++w) off += wtot[w * 4 + h];
            pre[h] += off;
        }
#pragma unroll
        for (int h = 0; h < 3; ++h) {
            f32x4 o = {cum[0][h] + pre[h], cum[1][h] + pre[h], cum[2][h] + pre[h], cum[3][h] + pre[h]};
            *(f32x4*)(F2 + ((size_t)(b * NH + h0 + h) * SEQ + 4 * F.tid)) = o;
            u32x4* ka = (u32x4*)((char*)F2 + (WS_KA - WS_F2)) + ((size_t)(b * NH + h0 + h) * SEQ + 4 * F.tid) * 2;
#pragma unroll
            for (int j = 0; j < 4; ++j) { const float x = o[j]; const unsigned b0 = __float_as_uint(x) & 0xffff0000u; const float r1 = x - __uint_as_float(b0);
                const unsigned b1 = __float_as_uint(r1) & 0xffff0000u; const float r2 = r1 - __uint_as_float(b1); const unsigned b2 = __float_as_uint(r2) & 0xffff0000u;
                ka[2 * j] = (u32x4){(b0 >> 16) | b1, (b2 >> 16) | 0x3f800000u, 0x3f803f80u, 0u}; ka[2 * j + 1] = (u32x4){0u, 0u, 0u, 0u}; }
        }
        __syncthreads();
    }
}

__device__ __forceinline__ void pool_phase(Frame& F, const bf16* Z, const bf16* pwt  , const float* pscale  , bf16* mixed) {
    constexpr int VROWS = 79, VPITCH = 512, PPITCH = 528;
    LAS unsigned char* Vt = F.lds;
    LAS unsigned char* Pt = F.lds + 40960;
    const int lane = F.lane, hi = lane >> 5, r32 = lane & 31;
    const int gi = F.wave & 3, th = F.wave >> 2;
    bf16x8 bw[2][4];
#pragma unroll
    for (int ct = 0; ct < 2; ++ct)
#pragma unroll
        for (int s = 0; s < 4; ++s) bw[ct][s] = *(const bf16x8*)(pwt + (size_t)gi * 4096 + (ct * 32 + r32) * 64 + 16 * s + 8 * hi);
    u32x4 vpre[5];
#define POOL_FETCH(it_) do { const int b_ = (it_) >> 5, t0_ = ((it_) & 31) * 64; _Pragma("unroll") for (int i5 = 0; i5 < 5; ++i5) { const int i = F.tid + i5 * NTHREADS; \
        const int r = i >> 5, ch = i & 31, t = t0_ - 15 + r; vpre[i5] = (u32x4){0u, 0u, 0u, 0u}; \
        if (i < VROWS * 32 && t >= 0) vpre[i5] = *(const u32x4*)(Z + (size_t)(b_ * SEQ + t) * NZ + C_PV + ch * 8); } } while (0)
    if (F.bid < NB * 32) POOL_FETCH(F.bid);
    for (int it = F.bid; it < NB * 32; it += F.G) {
        const int b = it >> 5, t0 = (it & 31) * 64;
        u32x4 gpre[4];
#pragma unroll
        for (int i = 0; i < 4; ++i) { const int idx = F.tid + i * NTHREADS, tok = idx >> 5, ch = idx & 31; gpre[i] = *(const u32x4*)(Z + ((size_t)b * SEQ + t0 + tok) * NZ + C_PG + ch * 8); }
        __syncthreads();
#pragma unroll
        for (int i5 = 0; i5 < 5; ++i5) { const int i = F.tid + i5 * NTHREADS; const int r = i >> 5, ch = i & 31; if (i < VROWS * 32) *(LAS u32x4*)(Vt + r * VPITCH + ch * 16) = vpre[i5]; }
        if (it + F.G < NB * 32) POOL_FETCH(it + F.G);
        __syncthreads();
        {
            const int cp = F.tid & 127, tr = F.tid >> 7, g = cp >> 5, w = 2 << g;
            float s0 = 0.f, s1 = 0.f;
            const int rbase = 15 + 16 * tr;
            unsigned hv[15];
#pragma unroll
            for (int j = 1; j <= 15; ++j) hv[j - 1] = *(LAS unsigned*)(Vt + (rbase - j) * VPITCH + cp * 4);
            unsigned cv[16];
#pragma unroll
            for (int k = 0; k < 16; ++k) cv[k] = *(LAS unsigned*)(Vt + (rbase + k) * VPITCH + cp * 4);
            unsigned ov[16];
#pragma unroll
            for (int k = 0; k < 16; ++k) ov[k] = *(LAS unsigned*)(Vt + (rbase + k - w + 1) * VPITCH + cp * 4);
#pragma unroll
            for (int j = 1; j <= 15; ++j) if (j < w) { s0 += bflo(hv[j - 1]); s1 += bfhi(hv[j - 1]); }
#pragma unroll
            for (int k = 0; k < 16; ++k) {
                const int t = t0 + 16 * tr + k;
                const float v0 = bflo(cv[k]), v1 = bfhi(cv[k]);
                s0 += v0; s1 += v1;
                const float rc = __builtin_amdgcn_rcpf((float)((t + 1 < w) ? (t + 1) : w));
                const float p0 = s0 * rc - v0, p1 = s1 * rc - v1;
                *(LAS unsigned*)(Pt + (16 * tr + k) * PPITCH + cp * 4) = pk2(p0, p1);
                const unsigned vo = ov[k];
                s0 -= bflo(vo); s1 -= bfhi(vo);
            }
        }
        __syncthreads();
        f32x16 acc[2];
#pragma unroll
        for (int ct = 0; ct < 2; ++ct) acc[ct] = f32x16{};
#pragma unroll
        for (int s = 0; s < 4; ++s) {
            const bf16x8 a = *(LAS bf16x8*)(Pt + (th * 32 + r32) * PPITCH + (gi * 64 + 16 * s + 8 * hi) * 2);
#pragma unroll
            for (int ct = 0; ct < 2; ++ct) acc[ct] = __builtin_amdgcn_mfma_f32_32x32x16_bf16(a, bw[ct][s], acc[ct], 0, 0, 0);
        }
        {
            LAS float* Yt = (LAS float*)(F.lds + 81920);
#pragma unroll
            for (int ct = 0; ct < 2; ++ct)
#pragma unroll
                for (int r = 0; r < 16; ++r) Yt[(th * 32 + crow(r, hi)) * 260 + gi * 64 + ct * 32 + r32] = acc[ct][r];
            __syncthreads();
#pragma unroll
            for (int i = 0; i < 4; ++i) {
                const int idx = F.tid + i * NTHREADS, tok = idx >> 5, ch = idx & 31;
                const size_t row = (size_t)b * SEQ + t0 + tok;
                const f32x4 y0 = *(const LAS f32x4*)(Yt + tok * 260 + ch * 8), y1 = *(const LAS f32x4*)(Yt + tok * 260 + ch * 8 + 4);
                const f32x4 s0 = *(const f32x4*)(pscale + ch * 8), s1 = *(const f32x4*)(pscale + ch * 8 + 4);
                const u32x4 g = gpre[i];
                u32x4 o;
                o.x = pk2(y0[0] * s0[0] * silu_f(bflo(g.x)), y0[1] * s0[1] * silu_f(bfhi(g.x)));
                o.y = pk2(y0[2] * s0[2] * silu_f(bflo(g.y)), y0[3] * s0[3] * silu_f(bfhi(g.y)));
                o.z = pk2(y1[0] * s1[0] * silu_f(bflo(g.z)), y1[1] * s1[1] * silu_f(bfhi(g.z)));
                o.w = pk2(y1[2] * s1[2] * silu_f(bflo(g.w)), y1[3] * s1[3] * silu_f(bfhi(g.w)));
                __builtin_nontemporal_store(o, (u32x4*)(mixed + row * DM + ch * 8));
            }
        }
    }
#undef POOL_FETCH
    __syncthreads();
}

__device__ __forceinline__ unsigned key16(float s) {
    const unsigned bits = (unsigned)__half_as_ushort(__float2half_rn(s));
    return (bits & 0x8000u) ? (~bits & 0xffffu) : (bits | 0x8000u);
}
__device__ __forceinline__ float relu_i(float x) { const int i = __float_as_int(x); return __int_as_float(i > 0 ? i : 0); }
typedef short s16x2 __attribute__((ext_vector_type(2)));
typedef _Float16 h16x2 __attribute__((ext_vector_type(2)));
__device__ __forceinline__ unsigned key16x2(float s0, float s1) {
    const h16x2 hh = {(_Float16)s0, (_Float16)s1};
    const s16x2 p = __builtin_bit_cast(s16x2, hh);
    const s16x2 m = p >> (short)15;
    const unsigned pu = __builtin_bit_cast(unsigned, p), mu = __builtin_bit_cast(unsigned, m);
    return pu ^ (mu | 0x80008000u);
}
__device__ __forceinline__ void hist_find(const LAS unsigned* hrow, unsigned need, int lane, unsigned& bin, unsigned& above) {
    const u32x4 c4 = *(const LAS u32x4*)(hrow + 4 * lane);
    const unsigned s4 = (c4.x + c4.y) + (c4.z + c4.w);
    unsigned S = s4;
#pragma unroll
    for (int o = 1; o < 64; o <<= 1) { const unsigned n = __shfl_down(S, o); if (lane + o < 64) S += n; }
    const unsigned Sn = S - s4;
    const bool found = (S >= need) && (Sn < need);
    unsigned mybin = 0, myab = 0;
    {
        unsigned ab = Sn; bool done = false;
        const unsigned cc[4] = {c4.x, c4.y, c4.z, c4.w};
#pragma unroll
        for (int j = 3; j >= 0; --j) { if (!done && ab + cc[j] >= need) { mybin = 4 * lane + j; myab = ab; done = true; } if (!done) ab += cc[j]; }
    }
    const unsigned long long bal = __ballot(found);
    const int src = bal ? (int)__builtin_ctzll(bal) : 0;
    bin = __shfl(mybin, src); above = __shfl(myab, src);
}

__device__ __forceinline__ void hist_find_pk(const LAS unsigned* hrow, int shift, unsigned need, int lane, unsigned& bin, unsigned& above) {
    const u32x4 c4 = *(const LAS u32x4*)(hrow + 4 * lane);
    const unsigned cc[4] = {(c4.x >> shift) & 0xffffu, (c4.y >> shift) & 0xffffu, (c4.z >> shift) & 0xffffu, (c4.w >> shift) & 0xffffu};
    const unsigned s4 = (cc[0] + cc[1]) + (cc[2] + cc[3]);
    unsigned S = s4;
#pragma unroll
    for (int o = 1; o < 64; o <<= 1) { const unsigned n = __shfl_down(S, o); if (lane + o < 64) S += n; }
    const unsigned Sn = S - s4;
    const bool found = (S >= need) && (Sn < need);
    unsigned mybin = 0, myab = 0;
    {
        unsigned ab = Sn; bool done = false;
#pragma unroll
        for (int j = 3; j >= 0; --j) { if (!done && ab + cc[j] >= need) { mybin = 4 * lane + j; myab = ab; done = true; } if (!done) ab += cc[j]; }
    }
    const unsigned long long bal = __ballot(found);
    const int src = bal ? (int)__builtin_ctzll(bal) : 0;
    bin = __shfl(mybin, src); above = __shfl(myab, src);
}

__device__ __forceinline__ void hist_find4(const LAS unsigned* hist, unsigned need0, unsigned need1, int lane, unsigned& bin0, unsigned& above0, unsigned& bin1, unsigned& above1) {
    const int hi = lane >> 5, n32 = lane & 31;
    const LAS unsigned* hr = hist + hi * 256 + 8 * n32;
    const u32x4 ca = *(const LAS u32x4*)(hr), cb = *(const LAS u32x4*)(hr + 4);
    const unsigned cc[8] = {ca.x, ca.y, ca.z, ca.w, cb.x, cb.y, cb.z, cb.w};
    const unsigned s8 = ((cc[0] + cc[1]) + (cc[2] + cc[3])) + ((cc[4] + cc[5]) + (cc[6] + cc[7]));
    unsigned S = s8;
#pragma unroll
    for (int o = 1; o < 32; o <<= 1) { const unsigned n = __shfl_down(S, o); if (n32 + o < 32) S += n; }
    const unsigned Sn = S - s8;
    unsigned mb[2] = {0u, 0u}, ma[2] = {0u, 0u}; bool fnd[2];
#pragma unroll
    for (int sl = 0; sl < 2; ++sl) {
        const unsigned need = sl ? need1 : need0, St = (S >> (16 * sl)) & 0xffffu, Snt = (Sn >> (16 * sl)) & 0xffffu;
        fnd[sl] = (St >= need) && (Snt < need);
        unsigned ab = Snt; bool done = false;
#pragma unroll
        for (int j = 7; j >= 0; --j) { const unsigned cj = (cc[j] >> (16 * sl)) & 0xffffu; if (!done && ab + cj >= need) { mb[sl] = 8 * n32 + j; ma[sl] = ab; done = true; } if (!done) ab += cj; }
    }
    const unsigned long long f0 = __ballot(fnd[0]), f1 = __ballot(fnd[1]);
    const unsigned h0 = hi ? (unsigned)(f0 >> 32) : (unsigned)f0, h1 = hi ? (unsigned)(f1 >> 32) : (unsigned)f1;
    const int s0 = 32 * hi + (h0 ? __builtin_ctz(h0) : 0), s1 = 32 * hi + (h1 ? __builtin_ctz(h1) : 0);
    bin0 = __shfl(mb[0], s0); above0 = __shfl(ma[0], s0); bin1 = __shfl(mb[1], s1); above1 = __shfl(ma[1], s1);
}

constexpr int SEL_KBUF = 0, SEL_HIST = 131072;
#define SEL_WL4(w0,w1,w2,w3,ba,bb,kt) do { unsigned keep_; asm volatile("s_mov_b32 %4, m0\n\ts_mov_b32 m0, %9\n\ts_nop 0\n\tv_writelane_b32 %0, %5, m0\n\tv_writelane_b32 %1, %6, m0\n\tv_writelane_b32 %2, %7, m0\n\tv_writelane_b32 %3, %8, m0\n\ts_mov_b32 m0, %4" \
        : "+v"(w0), "+v"(w1), "+v"(w2), "+v"(w3), "=&s"(keep_) : "s"((unsigned)(ba)), "s"((unsigned)(bb)), "s"((unsigned)((ba) >> 32)), "s"((unsigned)((bb) >> 32)), "s"(kt)); } while (0)
__device__ __forceinline__ void select_item(Frame& F, const bf16* Z, const bf16* ikf, unsigned* mask32, int b, int c) {
    const int lane = F.lane, hi = lane >> 5, n32 = lane & 31, wv = F.wave;
    LAS unsigned* kbuf = (LAS unsigned*)(F.lds + SEL_KBUF) + wv * 4096 + lane;
    LAS unsigned* hist = (LAS unsigned*)(F.lds + SEL_HIST) + wv * 512;
    const int N = 64 * (c + 1), NKT = N / 32;
    const size_t row0 = (size_t)b * SEQ + 64 * c;
    if (c < 4) {
        for (int i = F.tid; i < 64 * 64; i += NTHREADS) { const int q = i >> 6, kt = i & 63; mask32[(row0 + q) * 64 + kt] = (kt < NKT) ? 0xffffffffu : 0u; }
        return;
    }
    unsigned one_ = 1u, hi1_ = 65536u, zero_ = 0u; asm volatile("" : "+v"(one_), "+v"(hi1_), "+v"(zero_));
    const u32x4 zero4_ = {zero_, zero_, zero_, zero_};
    const int rho = n32;
    const int a_hi = (rho >> 2) & 1, a_slot = rho >> 4, a_head = (rho & 3) + 4 * ((rho >> 3) & 1);
    const bf16* kp = ikf + ((size_t)(b * (SEQ / 32)) * 128 + hi * 32 + n32) * 8;
    LAS unsigned* hrow = hist + hi * 256;
    bf16x8 afn[2]; u32x4 wwn[2];
#define SEL_FETCH_A(rt_) do { const int qb_ = wv * 8 + (rt_) * 4; const size_t ar_ = row0 + qb_ + 2 * a_hi + a_slot; \
        _Pragma("unroll") for (int s = 0; s < 2; ++s) afn[s] = *(const bf16x8*)(Z + ar_ * NZ + C_IQ + a_head * 32 + 16 * s + 8 * hi); \
        _Pragma("unroll") for (int sl = 0; sl < 2; ++sl) wwn[sl] = *(const u32x4*)(Z + (row0 + qb_ + 2 * hi + sl) * NZ + C_IW); } while (0)
    SEL_FETCH_A(0);
#pragma unroll 1
    for (int rt = 0; rt < 2; ++rt) {
        const int qbase = wv * 8 + rt * 4;
        bf16x8 af[2] = {afn[0], afn[1]};
        float w[16];
#pragma unroll
        for (int sl = 0; sl < 2; ++sl) {
            const u32x4 ww = wwn[sl];
            w[8 * sl + 0] = bflo(ww.x); w[8 * sl + 1] = bfhi(ww.x); w[8 * sl + 2] = bflo(ww.y); w[8 * sl + 3] = bfhi(ww.y);
            w[8 * sl + 4] = bflo(ww.z); w[8 * sl + 5] = bfhi(ww.z); w[8 * sl + 6] = bflo(ww.w); w[8 * sl + 7] = bfhi(ww.w);
        }
        if (rt == 0) SEL_FETCH_A(1);
#ifndef SELREP_A
#define SELREP_A 1
#endif
#ifndef SELREP_B
#define SELREP_B 1
#endif
#ifndef SELREP_C
#define SELREP_C 1
#endif
#pragma unroll 1
        for (int repa = 0; repa < SELREP_A; ++repa) {
        constexpr int GS = 2;
        bf16x8 f0[GS][2], f1[GS][2]; f32x16 aA[GS], aB[GS];
#define SEL_LOADG(f, g) do { _Pragma("unroll") for (int j = 0; j < GS; ++j) { int kq = GS * (g) + j; kq = kq < NKT ? kq : NKT - 1; \
            f[j][0] = *(const bf16x8*)(kp + (size_t)kq * 1024); f[j][1] = *(const bf16x8*)(kp + (size_t)kq * 1024 + 512); } } while (0)
#define SEL_MMAG(a, f) do { _Pragma("unroll") for (int j = 0; j < GS; ++j) { a[j] = __builtin_amdgcn_mfma_f32_32x32x16_bf16(af[0], f[j][0], f32x16{}, 0, 0, 0); \
            a[j] = __builtin_amdgcn_mfma_f32_32x32x16_bf16(af[1], f[j][1], a[j], 0, 0, 0); } } while (0)
#define SEL_VALG(a, g) do { _Pragma("unroll") for (int j = 0; j < GS; ++j) { float s0 = 0.0f, s1 = 0.0f, t0 = 0.0f, t1 = 0.0f; \
            _Pragma("unroll") for (int rr = 0; rr < 8; rr += 2) { const float a0 = a[j][rr], a1 = a[j][8 + rr], c0 = a[j][rr + 1], c1 = a[j][9 + rr]; \
                s0 = fmaf(relu_i(a0), w[rr], s0); s1 = fmaf(relu_i(a1), w[8 + rr], s1); t0 = fmaf(relu_i(c0), w[rr + 1], t0); t1 = fmaf(relu_i(c1), w[9 + rr], t1); } \
            if (GS * (g) + j < NKT) kbuf[(GS * (g) + j) * 64] = key16x2(s0 + t0, s1 + t1); } } while (0)
        SEL_LOADG(f0, 0); SEL_LOADG(f1, 1);
        SEL_MMAG(aA, f0);
        SEL_LOADG(f0, 2);
#pragma unroll 1
        for (int g = 0; GS * g < NKT; g += 2) {
            SEL_MMAG(aB, f1); SEL_LOADG(f1, g + 3); SEL_VALG(aA, g);
            SEL_MMAG(aA, f0); SEL_LOADG(f0, g + 4); SEL_VALG(aB, g + 1);
        }
#undef SEL_LOADG
#undef SEL_MMAG
#undef SEL_VALG
        }
#pragma unroll 1
        for (int repb = 0; repb < SELREP_B; ++repb) {
#pragma unroll
        for (int j = 0; j < 2; ++j) *(LAS u32x4*)(hist + j * 256 + 4 * lane) = zero4_;
        asm volatile("s_waitcnt lgkmcnt(0)" ::: "memory");
#pragma unroll 1
        for (int kt0 = 0; kt0 < NKT; kt0 += 8) {
            unsigned kk[8];
#pragma unroll
            for (int j = 0; j < 8; ++j) { int kq = kt0 + j; kq = kq < NKT ? kq : NKT - 1; kk[j] = kbuf[kq * 64]; }
#pragma unroll
            for (int j = 0; j < 8; j += 2) if (kt0 + j < NKT) {
#pragma unroll
                for (int i = 0; i < 2; ++i) { const unsigned k = kk[j + i];
                    (void)__hip_atomic_fetch_add(hrow + ((k >> 8) & 255u), one_, __ATOMIC_RELAXED, __HIP_MEMORY_SCOPE_WORKGROUP);
                    (void)__hip_atomic_fetch_add(hrow + (k >> 24), hi1_, __ATOMIC_RELAXED, __HIP_MEMORY_SCOPE_WORKGROUP); }
            }
        }
        asm volatile("s_waitcnt lgkmcnt(0)" ::: "memory");
        }
        unsigned b1_0, b1_1, nn0, nn1;
        { unsigned ab0, ab1; hist_find4(hist, 256u, 256u, lane, b1_0, ab0, b1_1, ab1); nn0 = 256u - ab0; nn1 = 256u - ab1; }
#pragma unroll
        for (int j = 0; j < 2; ++j) *(LAS u32x4*)(hist + j * 256 + 4 * lane) = zero4_;
        asm volatile("s_waitcnt lgkmcnt(0)" ::: "memory");
#pragma unroll 4
        for (int kt = 0; kt < NKT; ++kt) {
            const unsigned k = kbuf[kt * 64];
            if (((k >> 8) & 255u) == b1_0) (void)__hip_atomic_fetch_add(hrow + (k & 255u), one_, __ATOMIC_RELAXED, __HIP_MEMORY_SCOPE_WORKGROUP);
            if ((k >> 24) == b1_1) (void)__hip_atomic_fetch_add(hrow + ((k >> 16) & 255u), hi1_, __ATOMIC_RELAXED, __HIP_MEMORY_SCOPE_WORKGROUP);
        }
        asm volatile("s_waitcnt lgkmcnt(0)" ::: "memory");
        unsigned tau0, tau1, R0, R1;
        { unsigned bn0, bn1, ab0, ab1; hist_find4(hist, nn0, nn1, lane, bn0, ab0, bn1, ab1); tau0 = (b1_0 << 8) | bn0; tau1 = (b1_1 << 8) | bn1; R0 = nn0 - ab0; R1 = nn1 - ab1; }
        const bool easy = __all((R0 == (hrow[tau0 & 255u] & 0xffffu)) && (R1 == (hrow[tau1 & 255u] >> 16)));
#pragma unroll 1
        for (int repc = 0; repc < SELREP_C; ++repc) {
        int w0 = 0, w1 = 0, w2 = 0, w3 = 0;
        if (easy) {
#pragma unroll 4
            for (int kt = 0; kt < NKT; ++kt) {
                const unsigned k = kbuf[kt * 64];
                const unsigned long long e0 = __ballot((k & 0xffffu) >= tau0), e1 = __ballot((k >> 16) >= tau1);
                SEL_WL4(w0, w1, w2, w3, e0, e1, kt);
            }
        } else {
            unsigned cnt0 = 0, cnt1 = 0;
            const unsigned lowmask = (1u << n32) - 1u;
#pragma unroll 2
            for (int kt = 0; kt < NKT; ++kt) {
                const unsigned k = kbuf[kt * 64];
                const unsigned u0 = k & 0xffffu, u1 = k >> 16;
                unsigned long long g0 = __ballot(u0 > tau0), g1 = __ballot(u1 > tau1);
                const unsigned long long e0 = __ballot(u0 >= tau0), e1 = __ballot(u1 >= tau1);
                if (g0 != e0) {
                    const unsigned long long be = e0 & ~g0;
                    const unsigned mine = hi ? (unsigned)(be >> 32) : (unsigned)be;
                    const bool sel = (u0 > tau0) || ((u0 == tau0) && (cnt0 + __builtin_popcount(mine & lowmask)) < R0);
                    cnt0 += __builtin_popcount(mine);
                    g0 = __ballot(sel);
                }
                if (g1 != e1) {
                    const unsigned long long be = e1 & ~g1;
                    const unsigned mine = hi ? (unsigned)(be >> 32) : (unsigned)be;
                    const bool sel = (u1 > tau1) || ((u1 == tau1) && (cnt1 + __builtin_popcount(mine & lowmask)) < R1);
                    cnt1 += __builtin_popcount(mine);
                    g1 = __ballot(sel);
                }
                SEL_WL4(w0, w1, w2, w3, g0, g1, kt);
            }
        }
        unsigned* mrow = mask32 + (row0 + qbase) * 64 + lane;
        mrow[0] = (unsigned)w0; mrow[64] = (unsigned)w1; mrow[128] = (unsigned)w2; mrow[192] = (unsigned)w3;
        }
        asm volatile("s_waitcnt lgkmcnt(0)" ::: "memory");
    }
}

#undef SEL_FETCH_A
__device__ __forceinline__ void select_phase(Frame& F, const bf16* Z, const bf16* ikf, unsigned* mask32) {
    for (int v = F.bid; v < 256; v += F.G) {
        const int b = v & 15, s = v >> 4;
#pragma unroll 1
        for (int k = 0; k < 2; ++k) select_item(F, Z, ikf, mask32, b, k ? s : 31 - s);
    }
}

#ifdef DBG_SELECT_REF
__device__ __forceinline__ void select_ref_phase(Frame& F, const bf16* Z, unsigned* mask32) {
    LAS unsigned short* keys = (LAS unsigned short*)(F.lds + F.wave * 8192);
    LAS float* qs = (LAS float*)(F.lds + F.wave * 8192 + 4096);
    const int lane = F.lane;
    for (int qi = F.bid * NWAVES + F.wave; qi < MTOK; qi += F.G * NWAVES) {
        const int t = qi % SEQ, b = qi / SEQ, c = t / 64, N = 64 * (c + 1);
        if (N <= 256) { mask32[(size_t)qi * 64 + lane] = (lane < N / 32) ? 0xffffffffu : 0u; continue; }
        for (int i = lane; i < 256; i += 64) qs[i] = bf2f(Z[(size_t)qi * NZ + C_IQ + i]);
        asm volatile("s_waitcnt lgkmcnt(0)" ::: "memory");
        for (int i = 0; i < N / 64; ++i) {
            const int key = lane + 64 * i;
            const bf16* kr = Z + ((size_t)b * SEQ + key) * NZ + C_IK;
            u32x4 kw[4];
#pragma unroll
            for (int d = 0; d < 4; ++d) kw[d] = ((const u32x4*)kr)[d];
            float sc = 0.f;
#pragma unroll 1
            for (int h = 0; h < 8; ++h) { float dot = 0.f;
#pragma unroll
                for (int d = 0; d < 4; ++d) {
                    dot = fmaf(qs[h * 32 + 8 * d + 0], bflo(kw[d].x), dot); dot = fmaf(qs[h * 32 + 8 * d + 1], bfhi(kw[d].x), dot);
                    dot = fmaf(qs[h * 32 + 8 * d + 2], bflo(kw[d].y), dot); dot = fmaf(qs[h * 32 + 8 * d + 3], bfhi(kw[d].y), dot);
                    dot = fmaf(qs[h * 32 + 8 * d + 4], bflo(kw[d].z), dot); dot = fmaf(qs[h * 32 + 8 * d + 5], bfhi(kw[d].z), dot);
                    dot = fmaf(qs[h * 32 + 8 * d + 6], bflo(kw[d].w), dot); dot = fmaf(qs[h * 32 + 8 * d + 7], bfhi(kw[d].w), dot); }
                sc = fmaf(fmaxf(dot, 0.f), bf2f(Z[(size_t)qi * NZ + C_IW + h]), sc); }
            keys[key] = (unsigned short)key16(sc);
        }
        asm volatile("s_waitcnt lgkmcnt(0)" ::: "memory");
        unsigned tau = 0;
        for (int bit = 15; bit >= 0; --bit) {
            const unsigned cand = tau | (1u << bit); unsigned cnt = 0;
            for (int i = 0; i < N / 64; ++i) cnt += __builtin_popcountll(__ballot((unsigned)keys[lane + 64 * i] >= cand));
            if (cnt >= 256u) tau = cand;
        }
        unsigned cgt = 0;
        for (int i = 0; i < N / 64; ++i) cgt += __builtin_popcountll(__ballot((unsigned)keys[lane + 64 * i] > tau));
        const unsigned R = 256u - cgt; unsigned run = 0;
        for (int i = 0; i < 32; ++i) {
            unsigned long long bs = 0ull;
            if (i < N / 64) {
                const unsigned u = keys[lane + 64 * i];
                const unsigned long long be = __ballot(u == tau);
                const unsigned rank = run + __builtin_popcountll(be & ((1ull << lane) - 1ull));
                run += __builtin_popcountll(be);
                bs = __ballot(u > tau || (u == tau && rank < R));
            }
            if (lane == 0) { mask32[(size_t)qi * 64 + 2 * i] = (unsigned)bs; mask32[(size_t)qi * 64 + 2 * i + 1] = (unsigned)(bs >> 32); }
        }
    }
}
#endif

__device__ __forceinline__ void glds16(const void* gsrc, unsigned lds_dst) {
    unsigned keep;
    asm volatile("s_mov_b32 %0, m0\n\ts_mov_b32 m0, %2\n\ts_nop 0\n\tglobal_load_lds_dwordx4 %1, off\n\ts_mov_b32 m0, %0" : "=&s"(keep) : "v"(gsrc), "s"(lds_dst) : "memory");
}
__device__ __forceinline__ void glds16s(const void* sbase, unsigned voff, unsigned lds_dst) {
    unsigned keep;
    asm volatile("s_mov_b32 %0, m0\n\ts_mov_b32 m0, %3\n\ts_nop 0\n\tglobal_load_lds_dwordx4 %1, %2\n\ts_mov_b32 m0, %0" : "=&s"(keep) : "v"(voff), "s"(sbase), "s"(lds_dst) : "memory");
}
__device__ __forceinline__ unsigned hilo(float f) { const unsigned ph = cvtpk_s(f, 0.f) & 0xffffu; const float hf = __uint_as_float(ph << 16); return ph | (cvtpk_s(f - hf, 0.f) << 16); }
__device__ __forceinline__ float mask_sel(float v, unsigned m) { const unsigned u = __float_as_uint(v); return __uint_as_float((u & m) | (0xff800000u & ~m)); }
namespace att2 {
#define SBAR() __builtin_amdgcn_sched_barrier(0)
__device__ __forceinline__ void cmask(f32x16&p0,f32x16&p1,int jb,int qrel,int hi){
  const float NEG=-INFINITY; int kb=64*jb+4*hi;
  #pragma unroll
  for(int r=0;r<16;++r){int kv=kb+(r&3)+8*(r>>2); if(kv>qrel)p0[r]=NEG; if(kv+32>qrel)p1[r]=NEG;}
}

constexpr int NSLOT=3, SLOTB=8192;
constexpr int NW=8,QBLK=32,QB=256,KVBLK=64;
constexpr int LDS_K=0, LDS_V=NSLOT*SLOTB, LDS_WS=2*NSLOT*SLOTB, LDS_OST=LDS_WS+NW*64*4, LDS_X=LDS_OST+NW*4096, LDS_BYTES=LDS_X+65536;
__device__ __forceinline__ float max3f(float a,float b,float c){float r;asm("v_max3_f32 %0, %1, %2, %3":"=v"(r):"v"(a),"v"(b),"v"(c));return r;}
__device__ __forceinline__ float max2f(float a,float b){float r;asm("v_max_f32_e32 %0, %1, %2":"=v"(r):"v"(a),"v"(b));return r;}
__device__ __forceinline__ float fadd_s(float a,float b){float r;asm("v_add_f32_e32 %0, %1, %2":"=v"(r):"v"(a),"v"(b));return r;}
__device__ __forceinline__ float fsub_s(float a,float b){float r;asm("v_sub_f32_e32 %0, %1, %2":"=v"(r):"v"(a),"v"(b));return r;}
#define WAIT_BAR(N) asm volatile("s_waitcnt vmcnt(" #N ") lgkmcnt(0)\n\ts_barrier":::"memory")

__device__ __forceinline__ void qkt(f32x16&p0,f32x16&p1,const char*Kslot,const bf16x8*qr,int r32,int hi){
  const char*kb=Kslot+hi*1024+r32*16;
  #pragma unroll
  for(int d0=0;d0<4;++d0){
    const bf16x8 b0=*reinterpret_cast<const bf16x8*>(kb+d0*2048);
    const bf16x8 b1=*reinterpret_cast<const bf16x8*>(kb+d0*2048+512);
    p0=__builtin_amdgcn_mfma_f32_32x32x16_bf16(b0,qr[d0],p0,0,0,0);p1=__builtin_amdgcn_mfma_f32_32x32x16_bf16(b1,qr[d0],p1,0,0,0);}
}
typedef __attribute__((address_space(3))) const char* lds_cptr;
typedef short v4i16_t __attribute__((ext_vector_type(4)));
__device__ __forceinline__ void kload8(bf16x8*kf,lds_cptr kp){
  kf[0]=*(const __attribute__((address_space(3))) bf16x8*)(kp);      kf[1]=*(const __attribute__((address_space(3))) bf16x8*)(kp+512);
  kf[2]=*(const __attribute__((address_space(3))) bf16x8*)(kp+2048); kf[3]=*(const __attribute__((address_space(3))) bf16x8*)(kp+2560);
  kf[4]=*(const __attribute__((address_space(3))) bf16x8*)(kp+4096); kf[5]=*(const __attribute__((address_space(3))) bf16x8*)(kp+4608);
  kf[6]=*(const __attribute__((address_space(3))) bf16x8*)(kp+6144); kf[7]=*(const __attribute__((address_space(3))) bf16x8*)(kp+6656);
}
__device__ __forceinline__ void kload2(bf16x8*kf,lds_cptr kp,int j){ kf[2*j]=*(const __attribute__((address_space(3))) bf16x8*)(kp+j*2048); kf[2*j+1]=*(const __attribute__((address_space(3))) bf16x8*)(kp+j*2048+512); }
__device__ __forceinline__ s16x4 vtr(lds_cptr p){ return __builtin_bit_cast(s16x4,__builtin_amdgcn_ds_read_tr16_b64_v4i16((__attribute__((address_space(3))) v4i16_t*)p)); }
__device__ __forceinline__ float rowmax(const f32x16&p0,const f32x16&p1){
  float a=max3f(p0[0],p0[1],p1[0]),b=max3f(p0[2],p0[3],p1[1]);a=max3f(a,p1[2],p1[3]);
  #pragma unroll
  for(int r=4;r<16;r+=4){a=max3f(a,p0[r],p0[r+1]);b=max3f(b,p0[r+2],p0[r+3]);a=max3f(a,p1[r],p1[r+1]);b=max3f(b,p1[r+2],p1[r+3]);}
  const float m=max2f(a,b);
  auto rr=__builtin_amdgcn_permlane32_swap(__float_as_uint(m),__float_as_uint(m),false,false);
  return max2f(__uint_as_float(rr[0]),__uint_as_float(rr[1]));
}
__device__ __forceinline__ void pv(f32x16*o,int vb,bf16x8 pa0,bf16x8 pa1,bf16x8 pa2,bf16x8 pa3){
  #pragma unroll
  for(int d0=0;d0<2;++d0){s16x4 lo[4],hi[4];
    #pragma unroll
    for(int ks=0;ks<4;++ks){
      asm volatile("ds_read_b64_tr_b16 %0,%1 offset:%c2":"=&v"(lo[ks]):"v"(vb),"i"(d0*4096+ks*1024):"memory");
      asm volatile("ds_read_b64_tr_b16 %0,%1 offset:%c2":"=&v"(hi[ks]):"v"(vb),"i"(d0*4096+ks*1024+512):"memory");}
    asm volatile("s_waitcnt lgkmcnt(0)":::"memory");SBAR();
    #define PK(k) (bf16x8){lo[k][0],lo[k][1],lo[k][2],lo[k][3],hi[k][0],hi[k][1],hi[k][2],hi[k][3]}
    o[d0]=__builtin_amdgcn_mfma_f32_32x32x16_bf16(pa0,PK(0),o[d0],0,0,0);
    o[d0]=__builtin_amdgcn_mfma_f32_32x32x16_bf16(pa1,PK(1),o[d0],0,0,0);
    o[d0]=__builtin_amdgcn_mfma_f32_32x32x16_bf16(pa2,PK(2),o[d0],0,0,0);
    o[d0]=__builtin_amdgcn_mfma_f32_32x32x16_bf16(pa3,PK(3),o[d0],0,0,0);
    #undef PK
  }
}

template<bool FOX,int THRL,bool LATE> __device__ __forceinline__ void attn_unit(int tid,int b,int h,int qb,const bf16*Z,const float*F2,const unsigned*mask32,bf16*mixed,char*shm,
    bool pre,bool hasn,bool nfox,int bn,int hn,int qbn,bf16x8 (&qr)[4],float&fq2){
  asm volatile("":"+v"(tid));
  const int lane=tid&63,r32=lane&31,hi=lane>>5; const int wid=__builtin_amdgcn_readfirstlane(tid>>6);
  constexpr int CQ=FOX?C_FQ:C_DQ, CK=FOX?C_FK:C_DK, CV=FOX?C_FV:C_DV, CG=FOX?C_FG:C_DG, CO=FOX?640:256, DMP=NZ;
  const long rowbase=(long)b*SEQ; const int q0=qb*QB;
  const bf16*Qw=Z+(rowbase+q0+wid*QBLK)*DMP+CQ+h*64;
  const bf16*Kh=Z+rowbase*DMP+CK+h*64,*Vh=Z+rowbase*DMP+CV+h*64;
  const float*F2r=F2+(long)(b*NH+h)*SEQ;
  const int NT=(q0+QB)/KVBLK;
  const unsigned lds0=(unsigned)(uintptr_t)shm;
  float*wsf=(float*)(shm+LDS_WS)+wid*64;
  const unsigned koff=(unsigned)(lane*DMP+wid*8)*2u;
  const unsigned voff=(unsigned)((16*(wid&3)+(lane>>2))*DMP+(wid>>2)*32+(lane&3)*8)*2u;
  const unsigned kdst=lds0+LDS_K+wid*1024, vdst=lds0+LDS_V+wid*1024;
  #define DMA_K(t,slot) glds16s(Kh+(long)(t)*KVBLK*DMP,koff,(unsigned)__builtin_amdgcn_readfirstlane(kdst+(slot)))
  #define DMA_V(t,slot) glds16s(Vh+(long)(t)*KVBLK*DMP,voff,(unsigned)__builtin_amdgcn_readfirstlane(vdst+(slot)))
  const int vb0=(int)(lds0+LDS_V)+((lane>>4)&1)*32+(lane&3)*8+(4*hi+((lane&15)>>2))*64;
  const char*Kbase=shm+LDS_K; bf16x8 kf[8];
  const lds_cptr shm3=(lds_cptr)shm; const lds_cptr kp0=shm3+LDS_K+hi*1024+r32*16; const lds_cptr vp0=shm3+LDS_V+((lane>>4)&1)*32+(lane&3)*8+(4*hi+((lane&15)>>2))*64;
  #define ISSUE_XK(F2r_,mrow_,Kh_,NT_) do{ \
    if(FOX){ const char*kar_=(const char*)F2+(WS_KA-WS_F2)+((const char*)(F2r_)-(const char*)F2)*8; for(int p=wid;p<2*(NT_);p+=8) glds16s(kar_+p*1024,(unsigned)lane*16u,(unsigned)__builtin_amdgcn_readfirstlane(lds0+LDS_X+p*1024)); } \
    else{ for(int p=wid;p<2*(NT_);p+=8) glds16s(mask32+((long)((mrow_)+(p&3)*64))*64+(p>>2)*4,(unsigned)lane*256u,(unsigned)__builtin_amdgcn_readfirstlane(lds0+LDS_X+p*1024)); } \
    glds16s((Kh_),koff,(unsigned)__builtin_amdgcn_readfirstlane(kdst)); }while(0)
  #define ISSUE_XKR(fx_,F2r_,mrow_,Kh_,NT_) do{ \
    if(fx_){ const char*kar_=(const char*)F2+(WS_KA-WS_F2)+((const char*)(F2r_)-(const char*)F2)*8; for(int p=wid;p<2*(NT_);p+=8) glds16s(kar_+p*1024,(unsigned)lane*16u,(unsigned)__builtin_amdgcn_readfirstlane(lds0+LDS_X+p*1024)); } \
    else{ for(int p=wid;p<2*(NT_);p+=8) glds16s(mask32+((long)((mrow_)+(p&3)*64))*64+(p>>2)*4,(unsigned)lane*256u,(unsigned)__builtin_amdgcn_readfirstlane(lds0+LDS_X+p*1024)); } \
    glds16s((Kh_),koff,(unsigned)__builtin_amdgcn_readfirstlane(kdst)); }while(0)
  #define LOADQR(fx_,Qw_,F2r_,qrow_) do{ _Pragma("unroll") for(int d0=0;d0<4;++d0)qr[d0]=*reinterpret_cast<const bf16x8*>(&(Qw_)[(long)r32*DMP+d0*16+hi*8]); fq2=(fx_)?(F2r_)[(qrow_)+r32]:0.f; }while(0)
  #define LOADQ(Qw_,F2r_,qrow_) do{ _Pragma("unroll") for(int d0=0;d0<4;++d0)qr[d0]=*reinterpret_cast<const bf16x8*>(&(Qw_)[(long)r32*DMP+d0*16+hi*8]); fq2=FOX?(F2r_)[(qrow_)+r32]:0.f; }while(0)
  if(!pre){ ISSUE_XK(F2r,rowbase+q0,Kh,NT); DMA_V(0,0); DMA_K(1,SLOTB);
    LOADQ(Qw,F2r,q0+wid*QBLK); DMA_K(2,2*SLOTB); }
  else { DMA_V(0,0); }
  float mhat=FOX?-fq2:0.f;f32x16 o[2];o[0]=f32x16{};o[1]=f32x16{};
  bf16x8 qa=bf16x8{};
  bf16x8 onesa=bf16x8{}; if(!FOX){ int oc2_=0x3f80; asm volatile("":"+v"(oc2_)); const unsigned o1_=hi?0u:((unsigned)oc2_<<16), o2_=hi?0u:((unsigned)oc2_|((unsigned)oc2_<<16)); const u32x4 oa_={0u,o1_,o2_,0u}; onesa=__builtin_bit_cast(bf16x8,oa_); }
  const lds_cptr lutp=(lds_cptr)shm+149504;
  #define MKQA() do{ { const float nm_=-mhat; const unsigned b0_=__float_as_uint(nm_)&0xffff0000u; const float r1_=nm_-__uint_as_float(b0_); const unsigned b1_=__float_as_uint(r1_)&0xffff0000u; \
      const float r2_=r1_-__uint_as_float(b1_); const unsigned b2_=__float_as_uint(r2_)&0xffff0000u; const unsigned on_=hi?0u:0xffffffffu; \
      const u32x4 q_={0xbf80bf80u&on_,(0xbf80u|b0_)&on_,((b1_>>16)|b2_)&on_,0u}; qa=__builtin_bit_cast(bf16x8,q_); } }while(0)
  MKQA();
  f32x4 ls={0.f,0.f,0.f,0.f}; bf16x8 onesb; { int oc_=0x3f80; asm volatile("":"+v"(oc_)); const short ov_=(lane==0||lane==32||lane==17||lane==49)?(short)oc_:(short)0; onesb=(bf16x8){ov_,ov_,ov_,ov_,ov_,ov_,ov_,ov_}; }
  const lds_cptr xp0=(lds_cptr)shm+LDS_X;
  const int qrel=wid*QBLK+r32;
  #define INIT(X0,X1,tt) do{ const float nm_=-mhat; if(FOX){ const lds_cptr kp_=xp0+((64*(tt)+r32)*32+hi*16); \
      const bf16x8 ka0_=*(const __attribute__((address_space(3))) bf16x8*)(kp_), ka1_=*(const __attribute__((address_space(3))) bf16x8*)(kp_+1024); \
      X0=__builtin_amdgcn_mfma_f32_32x32x16_bf16(ka0_,qa,f32x16{},0,0,0); X1=__builtin_amdgcn_mfma_f32_32x32x16_bf16(ka1_,qa,f32x16{},0,0,0); (void)nm_; } else { \
      const u32x2 mw_=*(const __attribute__((address_space(3))) u32x2*)(xp0+((((tt)>>1)*256+wid*32+r32)*16+((tt)&1)*8)); const unsigned wl_=mw_.x>>(4*hi), wh_=mw_.y>>(4*hi); \
      _Pragma("unroll") for(int i_=0;i_<4;++i_){ const f32x4 va_=*(const __attribute__((address_space(3))) f32x4*)(lutp+((wl_>>(8*i_))&15u)*16u), vb_=*(const __attribute__((address_space(3))) f32x4*)(lutp+((wh_>>(8*i_))&15u)*16u); \
        _Pragma("unroll") for(int j_=0;j_<4;++j_){ X0[4*i_+j_]=va_[j_]; X1[4*i_+j_]=vb_[j_]; } } \
      X0=__builtin_amdgcn_mfma_f32_32x32x16_bf16(onesa,qa,X0,0,0,0); X1=__builtin_amdgcn_mfma_f32_32x32x16_bf16(onesa,qa,X1,0,0,0); (void)nm_; } }while(0)
  #define CMASK(P0,P1,t) do{ if(FOX){int jb_=(t)-(NT-4); if(jb_>=(wid>>1))cmask(P0,P1,jb_,qrel,hi);} }while(0)
  bool resc=false;
  #define START(P0,P1) do{ const float rm=rowmax(P0,P1); resc=false; \
    { const float dl=__builtin_fmaxf(rm,0.f); mhat=fadd_s(mhat,dl); \
      _Pragma("unroll") for(int r=0;r<16;++r){P0[r]=fsub_s(P0[r],dl);P1[r]=fsub_s(P1[r],dl);} \
      } \
    if(!LATE){ _Pragma("unroll") for(int r=0;r<16;++r)P0[r]=__builtin_amdgcn_exp2f(P0[r]); } }while(0)
  #define RESC() do{ if(resc){ asm volatile("s_waitcnt lgkmcnt(0)":::"memory"); \
      _Pragma("unroll") for(int d_=0;d_<2;++d_) _Pragma("unroll") for(int r=0;r<16;++r)o[d_][r]*=wsf[crow(r,hi)]; \
      _Pragma("unroll") for(int j_=0;j_<4;++j_)ls[j_]*=wsf[16*(lane&1)+4*(lane>>4)+j_]; } }while(0)
  f32x16 pA0,pA1,pB0,pB1;
  int sl_prev=0,sl_cur=0,sl_next=SLOTB;
  #define ROT() do{sl_prev=sl_cur;sl_cur=sl_next;sl_next=(sl_next==(NSLOT-1)*SLOTB)?0:sl_next+SLOTB;}while(0)
  WAIT_BAR(3);
  INIT(pA0,pA1,0);
  qkt(pA0,pA1,Kbase,qr,r32,hi);asm volatile("s_nop 15\n\ts_nop 7":"+v"(pA0),"+v"(pA1));CMASK(pA0,pA1,0);
  START(pA0,pA1); MKQA();
  INIT(pB0,pB1,1);
  if(!LATE){ _Pragma("unroll") for(int r=0;r<16;++r)pA1[r]=__builtin_amdgcn_exp2f(pA1[r]); }
  WAIT_BAR(0);
  DMA_K(3,0);DMA_V(1,SLOTB);
  ROT();
  kload8(kf,kp0+sl_cur);
  WAIT_BAR(2);
  s16x4 vlo[8],vhi[8]; u32x4 pw0,pw1,pw2,pw3;
  #define PKW(P,B) cvtpk_s(P[B],P[B+1])
  #define PAF(k) __builtin_bit_cast(bf16x8,pw##k)
  #define VFR(i) (bf16x8){vlo[i][0],vlo[i][1],vlo[i][2],vlo[i][3],vhi[i][0],vhi[i][1],vhi[i][2],vhi[i][3]}
  #define PIN(x) asm volatile("":"+v"(x))
  #define MX3(a,b,c) __builtin_fmaxf(__builtin_fmaxf((a),(b)),(c))
  #define EX4(P,B) do{ P[B]=EX(P[B]); P[B+1]=EX(P[B+1]); P[B+2]=EX(P[B+2]); P[B+3]=EX(P[B+3]); }while(0)
  #define GAPA(MF,XP,XB,W0,W1,PW) do{ if(LIVE_){ MF; } if(LATE&&PL_&&(XB)>=0){ EX4(XP,((XB)<0?0:(XB))); } W0; W1; PIN(PW); SBAR(); }while(0)
  #define LSUM(k) ls=__builtin_amdgcn_mfma_f32_16x16x32_bf16(PAF(k),onesb,ls,0,0,0)
  #define EX(v) __builtin_amdgcn_exp2f(v)
  #define GAPB(MF,X,B) do{ MF; if(!LATE&&LIVE_){ X[B]=EX(X[B]); X[B+1]=EX(X[B+1]); X[B+2]=EX(X[B+2]); X[B+3]=EX(X[B+3]); PIN(X); } SBAR(); }while(0)
  #define VRD(i) do{ vlo[i]=vtr(vp_+(((i)>>2)*4096+((i)&3)*1024)); vhi[i]=vtr(vp_+(((i)>>2)*4096+((i)&3)*1024+512)); }while(0)
  #define KRD(G,j) do{ if(G){ kload2(kf,kp0+sl_next,j); SBAR(); } }while(0)
  #define STEP(C0,C1,P0,P1,t,GK,GV,GL,LIVE,PLIVE) do{ const bool LIVE_=(LIVE), PL_=(PLIVE); SBAR(); \
    const lds_cptr vp_=vp0+sl_prev; \
    if(LATE&&PL_){ EX4(P0,0); } \
    GAPA(C0=__builtin_amdgcn_mfma_f32_32x32x16_bf16(kf[0],qr[0],C0,0,0,0), P0,4,     pw0[0]=PKW(P0,0), pw0[1]=PKW(P0,2), pw0); \
    GAPA(C1=__builtin_amdgcn_mfma_f32_32x32x16_bf16(kf[1],qr[0],C1,0,0,0), P0,8,     pw0[2]=PKW(P0,4), pw0[3]=PKW(P0,6), pw0); \
    GAPA(C0=__builtin_amdgcn_mfma_f32_32x32x16_bf16(kf[2],qr[1],C0,0,0,0),   P0,12, pw1[0]=PKW(P0,8), pw1[1]=PKW(P0,10), pw1); \
    GAPA(C1=__builtin_amdgcn_mfma_f32_32x32x16_bf16(kf[3],qr[1],C1,0,0,0),   P1,0,   pw1[2]=PKW(P0,12),pw1[3]=PKW(P0,14), pw1); \
    GAPA(C0=__builtin_amdgcn_mfma_f32_32x32x16_bf16(kf[4],qr[2],C0,0,0,0),   P1,4,     pw2[0]=PKW(P1,0), pw2[1]=PKW(P1,2), pw2); \
    GAPA(C1=__builtin_amdgcn_mfma_f32_32x32x16_bf16(kf[5],qr[2],C1,0,0,0),   P1,8,     pw2[2]=PKW(P1,4), pw2[3]=PKW(P1,6), pw2); \
    GAPA(C0=__builtin_amdgcn_mfma_f32_32x32x16_bf16(kf[6],qr[3],C0,0,0,0),   P1,12, pw3[0]=PKW(P1,8), pw3[1]=PKW(P1,10), pw3); \
    GAPA(C1=__builtin_amdgcn_mfma_f32_32x32x16_bf16(kf[7],qr[3],C1,0,0,0),   P0,-1,       pw3[2]=PKW(P1,12),pw3[3]=PKW(P1,14), pw3); \
    if(GK){DMA_K((t)+3,sl_cur);} if(GV){DMA_V((t)+1,sl_next);} \
    if(LIVE_){ CMASK(C0,C1,t); \
    { float a=MX3(C0[0],C0[1],C1[0]),b=MX3(C0[2],C0[3],C1[1]); a=MX3(a,C1[2],C1[3]); \
      _Pragma("unroll") for(int r=4;r<16;r+=4){a=MX3(a,C0[r],C0[r+1]);b=MX3(b,C0[r+2],C0[r+3]);a=MX3(a,C1[r],C1[r+1]);b=MX3(b,C1[r+2],C1[r+3]);} \
      float rm=__builtin_fmaxf(a,b); { auto rr=__builtin_amdgcn_permlane32_swap(__float_as_uint(rm),__float_as_uint(rm),false,false); rm=__builtin_fmaxf(__uint_as_float(rr[0]),__uint_as_float(rr[1])); } \
      resc=false; \
      if(__builtin_expect(__any(rm>(float)THRL),0)){ const float dl=__builtin_fmaxf(rm,0.f); mhat+=dl; \
        _Pragma("unroll") for(int r=0;r<16;++r){C0[r]-=dl;C1[r]-=dl;} \
        const float f=__builtin_amdgcn_exp2f(-dl); if(hi==0)wsf[r32]=f; resc=true; MKQA(); } } } \
    else { resc=false; }     \
    if(GL){ INIT(P0,P1,(t)+1); } \
    if(PL_){ VRD(0); VRD(4); SBAR(); \
    VRD(1); SBAR(); GAPB(o[0]=__builtin_amdgcn_mfma_f32_32x32x16_bf16(PAF(0),VFR(0),o[0],0,0,0), C0,0); \
    VRD(5); SBAR(); GAPB(o[1]=__builtin_amdgcn_mfma_f32_32x32x16_bf16(PAF(0),VFR(4),o[1],0,0,0); LSUM(0), C0,4); \
    VRD(2); SBAR(); KRD(GL,0); GAPB(o[0]=__builtin_amdgcn_mfma_f32_32x32x16_bf16(PAF(1),VFR(1),o[0],0,0,0), C0,8); \
    VRD(6); SBAR(); KRD(GL,1); GAPB(o[1]=__builtin_amdgcn_mfma_f32_32x32x16_bf16(PAF(1),VFR(5),o[1],0,0,0); LSUM(1), C0,12); \
    VRD(3); SBAR(); KRD(GL,2); GAPB(o[0]=__builtin_amdgcn_mfma_f32_32x32x16_bf16(PAF(2),VFR(2),o[0],0,0,0), C1,0); \
    VRD(7); SBAR(); KRD(GL,3); GAPB(o[1]=__builtin_amdgcn_mfma_f32_32x32x16_bf16(PAF(2),VFR(6),o[1],0,0,0); LSUM(2), C1,4); \
    GAPB(o[0]=__builtin_amdgcn_mfma_f32_32x32x16_bf16(PAF(3),VFR(3),o[0],0,0,0), C1,8); \
    GAPB(o[1]=__builtin_amdgcn_mfma_f32_32x32x16_bf16(PAF(3),VFR(7),o[1],0,0,0); LSUM(3), C1,12); } \
    }while(0)
  int t=1;
  #undef CMASK
  #define CMASK(P0,P1,t) do{}while(0)
  for(;t+5<NT;t+=2){
    STEP(pB0,pB1,pA0,pA1,t,true,true,true,true,true);     WAIT_BAR(2); RESC(); ROT();
    STEP(pA0,pA1,pB0,pB1,t+1,true,true,true,true,true);   WAIT_BAR(2); RESC(); ROT();
  }
  #undef CMASK
  #define CMASK(P0,P1,t) do{ if(FOX){int jb_=(t)-(NT-4); if(jb_>=(wid>>1))cmask(P0,P1,jb_,qrel,hi);} }while(0)
  #define ENDW(tt) do{ if((tt)+3<NT){WAIT_BAR(2);} else if((tt)+2<NT){WAIT_BAR(1);} else {WAIT_BAR(0);} }while(0)
  const int TW=NT-4+(wid>>1);
  for(;t+1<NT;t+=2){
    STEP(pB0,pB1,pA0,pA1,t,(t+3<NT),(t+1<NT),((t+1<NT)&&(t+1<=TW)),(t<=TW),(t-1<=TW));       ENDW(t);   RESC(); ROT();
    STEP(pA0,pA1,pB0,pB1,t+1,(t+4<NT),(t+2<NT),((t+2<NT)&&(t+2<=TW)),(t+1<=TW),(t<=TW));     ENDW(t+1); RESC(); ROT();
  }
  const long rbn=(long)bn*SEQ; const int q0n=qbn*QB, NTn=(q0n+QB)/KVBLK; const bf16*Khn=Z+rbn*DMP+(nfox?C_FK:C_DK)+hn*64; const float*F2n=F2+(long)(bn*NH+hn)*SEQ;
  if(hasn){ ISSUE_XKR(nfox,F2n,rbn+q0n,Khn,NTn);
    glds16s(Khn+(long)KVBLK*DMP,koff,(unsigned)__builtin_amdgcn_readfirstlane(kdst+SLOTB)); glds16s(Khn+(long)2*KVBLK*DMP,koff,(unsigned)__builtin_amdgcn_readfirstlane(kdst+2*SLOTB)); }
  STEP(pB0,pB1,pA0,pA1,NT-1,false,false,false,(TW==NT-1),(NT-2<=TW)); RESC();
  if(hasn){ const bf16*Qwn=Z+(rbn+q0n+wid*QBLK)*DMP+(nfox?C_FQ:C_DQ)+hn*64; LOADQR(nfox,Qwn,F2n,q0n+wid*QBLK); }
  const bf16*Gw=Z+(rowbase+q0+wid*QBLK)*DMP+CG+h*64; u32x4 gpre[4];
  _Pragma("unroll") for(int i=0;i<4;++i){const int row=i*8+(lane>>3),ch=lane&7; gpre[i]=*(const u32x4*)(Gw+(long)row*DMP+ch*8);}
  if(TW==NT-1){
    if(LATE&&TW==NT-1){ _Pragma("unroll") for(int r=0;r<16;++r){pB0[r]=EX(pB0[r]);pB1[r]=EX(pB1[r]);} }
    pw0=(u32x4){PKW(pB0,0),PKW(pB0,2),PKW(pB0,4),PKW(pB0,6)};pw1=(u32x4){PKW(pB0,8),PKW(pB0,10),PKW(pB0,12),PKW(pB0,14)};pw2=(u32x4){PKW(pB1,0),PKW(pB1,2),PKW(pB1,4),PKW(pB1,6)};pw3=(u32x4){PKW(pB1,8),PKW(pB1,10),PKW(pB1,12),PKW(pB1,14)};
    SBAR(); pv(o,vb0+sl_cur,PAF(0),PAF(1),PAF(2),PAF(3)); LSUM(0); LSUM(1); LSUM(2); LSUM(3); }
  #undef PKW
  #undef PAF
  #undef VFR
  #undef PIN
  #undef MX3
  #undef GAPA
  #undef EX4
  #undef LSUM
  #undef GAPB
  #undef EX
  #undef VRD
  #undef KRD
  #undef STEP
  #undef ENDW
  if((lane&15)<2){ _Pragma("unroll") for(int j_=0;j_<4;++j_)wsf[32+16*(lane&15)+4*(lane>>4)+j_]=ls[j_]; } asm volatile("s_waitcnt lgkmcnt(0)":::"memory");
  float rli[16];
  #pragma unroll
  for(int r=0;r<16;++r)rli[r]=__builtin_amdgcn_rcpf(wsf[32+crow(r,hi)]);
  bf16*Ow=mixed+(rowbase+q0+wid*QBLK)*DM+CO+h*64;
  { bf16*stg=(bf16*)(shm+LDS_OST)+wid*2048;
    #pragma unroll
    for(int r=0;r<16;++r){const int orow=crow(r,hi);
      const unsigned pk_=cvtpk_s(o[0][r]*rli[r],o[1][r]*rli[r]);
      stg[orow*64+r32]=(bf16)(pk_&0xffffu); stg[orow*64+32+r32]=(bf16)(pk_>>16);}
    asm volatile("s_waitcnt lgkmcnt(0)":::"memory");
    #pragma unroll
    for(int i=0;i<4;++i){const int row=i*8+(lane>>3),ch=lane&7; const u32x4 v=*(const u32x4*)(stg+row*64+ch*8); const u32x4 g=gpre[i]; u32x4 ov;
      ov.x=pk2(bflo(v.x)*silu_f(bflo(g.x)),bfhi(v.x)*silu_f(bfhi(g.x))); ov.y=pk2(bflo(v.y)*silu_f(bflo(g.y)),bfhi(v.y)*silu_f(bfhi(g.y)));
      ov.z=pk2(bflo(v.z)*silu_f(bflo(g.z)),bfhi(v.z)*silu_f(bfhi(g.z))); ov.w=pk2(bflo(v.w)*silu_f(bflo(g.w)),bfhi(v.w)*silu_f(bfhi(g.w)));
      __builtin_nontemporal_store(ov,(u32x4*)(Ow+(long)row*DM+ch*8));} }
  asm volatile("s_waitcnt lgkmcnt(0)\n\ts_barrier":::"memory");
  #undef DMA_K
  #undef DMA_V
  #undef ISSUE_XK
  #undef LOADQ
  #undef LOADQR
  #undef ISSUE_XKR
  #undef CMASK
  #undef INIT
  #undef MKQA
  #undef START
  #undef RESC
  #undef ROT
}

#undef SBAR
#undef WAIT_BAR
}

template <bool FOX>
__device__ __forceinline__ void attn_run(Frame& F, int xcd, int gq, int m, int pass, const bf16* Z, const float* F2, const unsigned* mask32, bf16* mixed, bf16x8 (&qr)[4], float& fq2) {
    const int nu = pass ? 2 : 4;
#pragma unroll 1
    for (int u = 0; u < nu; ++u) {
        const int j = pass ? 1 : (u >> 1) * 2, k = u & 1, sid = xcd * 24 + 8 * j + ((gq + j) & 7), bh = sid >> 1, b = bh / NH, h = bh % NH, qb = k ? m : 7 - m;
        const int un = u + 1; const bool cross = (un == nu);
        const int jn = (pass || cross) ? 1 : (un >> 1) * 2, kn = un & 1, sidn = xcd * 24 + 8 * jn + ((gq + jn) & 7), bhn = sidn >> 1;
        att2::attn_unit<FOX, 8, false>(F.tid, b, h, qb, Z, F2, mask32, mixed, F.ldsg, (u > 0) || (pass == 1), (un < nu) || (pass == 0), cross ? !FOX : FOX, bhn / NH, bhn % NH, kn ? m : 7 - m, qr, fq2);
    }
}
__device__ __forceinline__ void attn_phase(Frame& F, const bf16* Z, const float* F2, const unsigned* mask32, bf16* mixed) {
    for (int vb = F.bid; vb < 256; vb += F.G) {
        const int v = (F.G == 256) ? (vb & 7) * 32 + (vb >> 3) : vb;
        const int xcd = v >> 5, c = v & 31, gq = c >> 2, m = c & 3;
        bf16x8 qr[4]; float fq2 = 0.f;
#pragma unroll 1
        for (int pass = 0; pass < 2; ++pass) {
            const bool fox = (((gq + pass) & 1) == 0);
            if (fox) attn_run<true>(F, xcd, gq, m, pass, Z, F2, mask32, mixed, qr, fq2);
            else attn_run<false>(F, xcd, gq, m, pass, Z, F2, mask32, mixed, qr, fq2);
        }
    }
}

__device__ __forceinline__ void final_phase(Frame& F, const bf16* xb, float* xo, const float* part, const float* fg) {
    const int gw = F.bid * NWAVES + F.wave, NGW = F.G * NWAVES;
    f32x4 gv[4];
#pragma unroll
    for (int j = 0; j < 4; ++j) gv[j] = ((const f32x4*)fg)[64 * j + F.lane];
    for (int m0 = gw; m0 < MTOK; m0 += 4 * NGW) {
        float pv[4]; u32x2 w[4][4];
#pragma unroll
        for (int r = 0; r < 4; ++r) { const int m = m0 + r * NGW; pv[r] = 0.f; if (m < MTOK) { pv[r] = (F.lane < 16) ? part[(size_t)m * 16 + F.lane] : 0.f;
            const u32x2* xr = (const u32x2*)(xb + (size_t)m * DM) + F.lane;
#pragma unroll
            for (int j = 0; j < 4; ++j) w[r][j] = xr[64 * j]; } }
#pragma unroll
        for (int r = 0; r < 4; ++r) { const int m = m0 + r * NGW; if (m < MTOK) {
            const float s = wave_sum(pv[r]);
            const float rs = __builtin_amdgcn_rsqf(s * (1.0f / 1024.0f) + 1e-6f);
            f32x4* orow = (f32x4*)(xo + (size_t)m * DM) + F.lane;
#pragma unroll
            for (int j = 0; j < 4; ++j) { f32x4 v = {bflo(w[r][j].x), bfhi(w[r][j].x), bflo(w[r][j].y), bfhi(w[r][j].y)}; v = v * rs * gv[j]; __builtin_nontemporal_store(v, orow + 64 * j); } } }
    }
}

#define XB_TMO      128
#define XB_XCNT(j)  (256  + 64 * (j))
#define XB_XSUB(j)  (1280 + 64 * (j))
#define XB_XGEN(j)  (2304 + 64 * (j))
#define XB_TOP      3328
#define XB_TOPGEN   3392
#define XCD_BAR_WORDS 3456
#define XB_SPIN_CAP (1u << 18)

__device__ __forceinline__ unsigned xb_ld(unsigned* p)              { return __hip_atomic_load(p, __ATOMIC_RELAXED, __HIP_MEMORY_SCOPE_AGENT); }
__device__ __forceinline__ unsigned xb_add(unsigned* p, unsigned v) { return __hip_atomic_fetch_add(p, v, __ATOMIC_RELAXED, __HIP_MEMORY_SCOPE_AGENT); }
__device__ __forceinline__ unsigned xb_xcc_id() { return (unsigned)__builtin_amdgcn_s_getreg((3 << 11) | 20) & 0xFu; }
#define XB_SPIN(cond, bar) do { unsigned _sp = 0; while (cond) { __builtin_amdgcn_s_sleep(1); \
    if ((++_sp & 255u) == 0u) { if (xb_ld(&(bar)[XB_TMO])) break; if (_sp > XB_SPIN_CAP) { atomicAdd(&(bar)[XB_TMO], 1u); break; } } } } while (0)

struct XcdBarrier {
    unsigned* bar; unsigned x;
    int tid;
    volatile LAS unsigned* st;
};

__device__ __forceinline__ XcdBarrier xcd_barrier_post(unsigned* bar, volatile LAS unsigned* st) {
    XcdBarrier b; b.bar = bar; b.x = xb_xcc_id(); b.st = st; b.tid = (int)threadIdx.x;
    if (threadIdx.x == 0) (void)xb_add(&bar[XB_XCNT(b.x)], 1u);
    return b;
}
__device__ __forceinline__ void xcd_barrier_complete(unsigned* bar, unsigned x, unsigned& nloc, unsigned& nx) {
    const unsigned G = gridDim.x * gridDim.y * gridDim.z;
    unsigned sum, cnt, mine, sp = 0u;
    for (;;) {
        sum = 0u; cnt = 0u; mine = 0u;
#pragma unroll
        for (unsigned j = 0; j < 16; ++j) { const unsigned c = xb_ld(&bar[XB_XCNT(j)]); sum += c; cnt += (c > 0u) ? 1u : 0u; mine = (j == x) ? c : mine; }
        if (sum == G) break;
        __builtin_amdgcn_s_sleep(1);
        if ((++sp & 255u) == 0u) { if (xb_ld(&bar[XB_TMO])) break; if (sp > XB_SPIN_CAP) { atomicAdd(&bar[XB_TMO], 1u); break; } }
    }
    nloc = mine > 0u ? mine : 1u; nx = cnt > 0u ? cnt : 1u;
}

__device__ __forceinline__ void xcd_barrier(const XcdBarrier& b) {
    asm volatile("s_waitcnt vmcnt(0)" ::: "memory");
    __syncthreads();
    if (b.tid == 0) {
        unsigned* bar = b.bar;
        __builtin_amdgcn_s_waitcnt(0);
        unsigned nloc = b.st[0], nx = b.st[1];
        if (nloc == 0u) { xcd_barrier_complete(bar, b.x, nloc, nx); b.st[0] = nloc; b.st[1] = nx; }
        const unsigned old = xb_add(&bar[XB_XSUB(b.x)], 1u);
        const unsigned gen = old / nloc;
        if (old + 1u == (gen + 1u) * nloc) {
            __builtin_amdgcn_fence(__ATOMIC_RELEASE, "agent");
            asm volatile("s_waitcnt vmcnt(0)" ::: "memory");
            const unsigned og = xb_add(&bar[XB_TOP], 1u);
            const unsigned tg = og / nx;
            if (og + 1u == (tg + 1u) * nx) xb_add(&bar[XB_TOPGEN], 1u);
            else XB_SPIN(xb_ld(&bar[XB_TOPGEN]) == tg, bar);
            __builtin_amdgcn_fence(__ATOMIC_ACQUIRE, "agent");
            asm volatile("s_waitcnt vmcnt(0)" ::: "memory");
        } else {
            XB_SPIN(xb_ld(&bar[XB_TOPGEN]) == gen, bar);
            __builtin_amdgcn_fence(__ATOMIC_ACQUIRE, "agent");
            asm volatile("s_waitcnt vmcnt(0)" ::: "memory");
        }
    }
    __syncthreads();
}

struct Args { const float* x; const float* w_in; const float* norm_g; const float* pool_w; const float* pool_scale; const float* fox_bf; const float* w_out; const float* final_g;
              float* out; unsigned char* ws; int ph_lo, ph_hi; };
constexpr int N_PHASES = 18;

__global__ void __launch_bounds__(NTHREADS, 2) mk_fwd(Args a) {
    extern __shared__ __attribute__((aligned(16))) unsigned char lds_raw[];
    Frame F;
    F.lds = (LAS unsigned char*)lds_raw; F.ldsg = (char*)lds_raw;
    F.tid = threadIdx.x; F.lane = F.tid & 63; F.wave = __builtin_amdgcn_readfirstlane(F.tid >> 6);
    const int wave0_ = F.wave;
    F.G = gridDim.x; F.bid = blockIdx.x;
#if MK_FUSED
    volatile LAS unsigned* MISC = (volatile LAS unsigned*)(F.lds + LDS_BYTES - 64);
    if (threadIdx.x < 16) MISC[threadIdx.x] = 0u;
    if (threadIdx.x < 64) ((LAS unsigned*)(F.lds + LDS_LUT))[threadIdx.x] = ((threadIdx.x >> 2) >> (threadIdx.x & 3)) & 1u ? 0u : 0xff800000u;
    __syncthreads();
    (void)xcd_barrier_post((unsigned*)(a.ws + WS_CTL) + CW_BAR, MISC);
#define GRID_BAR() do { XcdBarrier bar_; bar_.bar = (unsigned*)(ws + WS_CTL) + CW_BAR; bar_.x = xb_xcc_id(); bar_.st = MISC; { int w2_ = wave0_; asm volatile("" : "+s"(w2_)); int t2_; asm volatile("v_mbcnt_lo_u32_b32 %0, -1, 0\n\tv_mbcnt_hi_u32_b32 %0, -1, %0" : "=v"(t2_)); bar_.tid = t2_ + 64 * w2_; } xcd_barrier(bar_); } while (0)
#else
#define GRID_BAR() do { } while (0)
#endif
#ifndef PHMASK
#define PHMASK 0x3f
#endif
#define FRAME_TID() do { int w_ = wave0_; asm volatile("" : "+s"(w_)); int t_; asm volatile("v_mbcnt_lo_u32_b32 %0, -1, 0\n\tv_mbcnt_hi_u32_b32 %0, -1, %0" : "=v"(t_)); t_ += 64 * w_;     F.tid = t_; F.lane = t_ & 63; F.wave = __builtin_amdgcn_readfirstlane(t_ >> 6); } while (0)
    int rep_ = 0; (void)rep_;
    for (int ph = a.ph_lo; ph < a.ph_hi; ++ph) {
        { int b_ = blockIdx.x; asm volatile("" : "+s"(b_)); F.bid = b_; int g_ = gridDim.x; asm volatile("" : "+s"(g_)); F.G = g_; }
        unsigned long long wsi_ = (unsigned long long)a.ws; asm volatile("" : "+s"(wsi_)); unsigned char* ws = (unsigned char*)(__attribute__((address_space(1))) unsigned char*)wsi_;
        bf16* Zb = (bf16*)(ws + WS_Z); bf16* XB = (bf16*)(ws + WS_XB); bf16* MIX = (bf16*)(ws + WS_MIX);
        float* PART = (float*)(ws + WS_PART); float* F2 = (float*)(ws + WS_F2);
        if (ph == 0) {
            FRAME_TID();
            if (PHMASK & 1)
            p0_prep(F, a.x, a.w_in, a.norm_g, a.pool_w, a.w_out, ws);
        } else if (ph == N_PHASES - 1) {
            FRAME_TID();
            if (PHMASK & 32) final_phase(F, XB, a.out, PART, a.final_g);
        } else {
            const int l = (ph - 1) >> 2, sub = (ph - 1) & 3;
            unsigned* MASK = (unsigned*)(ws + WS_MASK + (size_t)l * 8 * MiB);
            if (sub == 0 && (PHMASK & 2)) {
                FRAME_TID();
                pg8::Gemm g{XB, (const pg8::bf16_t*)(ws + WS_WIN) + (size_t)l * NZ * 1024, MTOK, NZ, DM};
                pg8::StaticOrder S; S.init(MTOK, NZ, F.G, F.bid, WGM_IN);
                LAS float* rtab = (LAS float*)(F.lds + 131072);
                asm volatile("s_waitcnt lgkmcnt(0)" ::: "memory");
                pg8::EpiZ E{Zb, NZ, PART, (bf16*)(ws + WS_IKF), rtab};
                pg8::gemm_phase<pg8::EpiZ, pg8::StaticOrder, PG8_ALIGN, PG8_SP2>(F.lds, g, S, E, F.tid);
            } else if (sub == 1 && (PHMASK & 4)) {
                FRAME_TID();
                scan_phase(F, Zb, a.fox_bf + l * NH, F2);
#if defined(REP_PART) && REP_PART == 1
                scan_phase(F, Zb, a.fox_bf + l * NH, F2); scan_phase(F, Zb, a.fox_bf + l * NH, F2);
#endif
                pool_phase(F, Zb, (const bf16*)(ws + WS_PW) + (size_t)l * 4 * 4096, a.pool_scale + l * 256, MIX);
#if defined(REP_PART) && REP_PART == 2
                pool_phase(F, Zb, (const bf16*)(ws + WS_PW) + (size_t)l * 4 * 4096, a.pool_scale + l * 256, MIX);
#endif
#if defined(REP_PART) && REP_PART == 3
                select_phase(F, Zb, (const bf16*)(ws + WS_IKF), MASK);
#endif
#ifdef DBG_SELECT_REF
                select_ref_phase(F, Zb, MASK);
#else
                select_phase(F, Zb, (const bf16*)(ws + WS_IKF), MASK);
#endif
            } else if (sub == 2 && (PHMASK & 8)) {
                FRAME_TID();
                attn_phase(F, Zb, F2, MASK, MIX);
            } else if (sub == 3 && (PHMASK & 16)) {
                FRAME_TID();
                pg8::Gemm g{MIX, (const pg8::bf16_t*)(ws + WS_WOUT) + (size_t)l * 1024 * 1024, MTOK, DM, DM};
                pg8::StaticOrder S; S.init(MTOK, DM, F.G, F.bid, WGM_OUT);
                pg8::EpiOut E{nullptr, nullptr, XB, PART};
                pg8::gemm_phase<pg8::EpiOut, pg8::StaticOrder, PG8_ALIGN, PG8_SP2>(F.lds, g, S, E, F.tid);
            }
        }
#ifdef REP_SUB
        if (ph >= 1 && ph < N_PHASES - 1 && ((ph - 1) & 3) == REP_SUB && rep_ == 0) { rep_ = 1; GRID_BAR(); --ph; continue; }
        rep_ = 0;
#endif
#ifdef REP_PH
        if (ph == REP_PH && rep_ < 4) { ++rep_; GRID_BAR(); --ph; continue; }
        rep_ = 0;
#endif
        if (ph + 1 < a.ph_hi) GRID_BAR();
    }
}

extern "C" void kernel_launch(void* const* d_in, const int* in_sizes, int n_in, void* d_out, int out_size, void* d_ws, size_t ws_size, hipStream_t stream) {
    static int grid = 0;
    if (grid == 0) {
        if (n_in != 8 || in_sizes[0] != MTOK * DM || out_size != MTOK * DM || ws_size < WS_END) {
            fprintf(stderr, "kernel_launch: unexpected shapes (n_in %d, in0 %d, out %d, ws %zu)\n", n_in, n_in > 0 ? in_sizes[0] : -1, out_size, ws_size); grid = -1; return; }
        int dev = 0, cus = 0, per_cu = 0;
        hipGetDevice(&dev); hipDeviceGetAttribute(&cus, hipDeviceAttributeMultiprocessorCount, dev);
        hipFuncSetAttribute((const void*)mk_fwd, hipFuncAttributeMaxDynamicSharedMemorySize, LDS_BYTES);
        hipOccupancyMaxActiveBlocksPerMultiprocessor(&per_cu, (const void*)mk_fwd, NTHREADS, LDS_BYTES);
        if (per_cu < 1) { fprintf(stderr, "kernel_launch: occupancy query says %d blocks per CU\n", per_cu); per_cu = 1; }
        (void)hipGetLastError();
        grid = cus;
    }
    if (grid < 0) return;
    (void)hipMemsetAsync((char*)d_ws + WS_CTL + (size_t)CW_BAR * 4, 0, (size_t)XCD_BAR_WORDS * 4, stream);
    Args a{};
    a.x = (const float*)d_in[0]; a.w_in = (const float*)d_in[1]; a.norm_g = (const float*)d_in[2]; a.pool_w = (const float*)d_in[3]; a.pool_scale = (const float*)d_in[4];
    a.fox_bf = (const float*)d_in[5]; a.w_out = (const float*)d_in[6]; a.final_g = (const float*)d_in[7];
    a.out = (float*)d_out; a.ws = (unsigned char*)d_ws;
#if MK_FUSED
    a.ph_lo = 0; a.ph_hi = N_PHASES;
    void* args[] = {&a};
    hipError_t e = hipLaunchCooperativeKernel((const void*)mk_fwd, dim3(grid), dim3(NTHREADS), args, LDS_BYTES, stream);
    if (e != hipSuccess) fprintf(stderr, "cooperative launch failed: %s (grid %d)\n", hipGetErrorString(e), grid);
#else
    for (int ph = 0; ph < N_PHASES; ++ph) {
        a.ph_lo = ph; a.ph_hi = ph + 1;
        hipLaunchKernelGGL(mk_fwd, dim3(grid), dim3(NTHREADS), LDS_BYTES, stream, a);
    }
#endif
}
```
